# Optimizing an MI355X kernel written in HIP

```python
import math
import jax, jax.numpy as jnp
from jax import lax
import numpy as np

D_MODEL = 1024
BATCH = 8
SEQ = 2048
DEPTH = 4

HEAD_DIM = 64
FOX_HEADS = 6
DIFF_HEADS = 4
DIFF_QK_DIM = 32
DIFF_V_DIM = 64
DSA_HEADS = 6
DSA_KV_DIM = 64
IDX_HEADS = 4
IDX_DIM = 64
DSA_TOPK = 256
ROPE_THETA = 500000.0
ROPE_FRACTION = 4
Q_BLOCK = 128
NORM_EPS = 1e-6
FFN_HIDDEN = -(-8 * D_MODEL // (3 * 256)) * 256

MIX_WIDTH = FOX_HEADS * HEAD_DIM + DIFF_HEADS * DIFF_V_DIM + DSA_HEADS * HEAD_DIM

SPLIT_SIZES = (
    FOX_HEADS * HEAD_DIM,
    FOX_HEADS * HEAD_DIM,
    FOX_HEADS * HEAD_DIM,
    FOX_HEADS,
    DIFF_HEADS * 2 * DIFF_QK_DIM,
    DIFF_HEADS * 2 * DIFF_QK_DIM,
    DIFF_HEADS * DIFF_V_DIM,
    DSA_HEADS * HEAD_DIM,
    DSA_KV_DIM,
    DSA_KV_DIM,
    IDX_HEADS * IDX_DIM,
    IDX_DIM,
    IDX_HEADS,
)
IN_WIDTH = sum(SPLIT_SIZES)

kernel_name = "hybrid_fox_diff_dsa_trunk"


def rms_norm(x, g):
    xf = x.astype(jnp.float32)
    y = xf * lax.rsqrt(jnp.mean(xf * xf, axis=-1, keepdims=True) + NORM_EPS)
    return (y * g.astype(jnp.float32)).astype(x.dtype)


def rope_tables(seq_len, head_dim):
    rot = head_dim // ROPE_FRACTION
    inv_freq = 1.0 / (ROPE_THETA ** (jnp.arange(0, rot, 2, dtype=jnp.float32) / rot))
    ang = jnp.arange(seq_len, dtype=jnp.float32)[:, None] * inv_freq[None, :]
    return jnp.cos(ang), jnp.sin(ang)


def partial_rope(x, cos, sin):
    rot = x.shape[-1] // ROPE_FRACTION
    half = rot // 2
    c = cos.astype(x.dtype)
    s = sin.astype(x.dtype)
    x1 = x[..., :half]
    x2 = x[..., half:rot]
    return jnp.concatenate([x1 * c - x2 * s, x2 * c + x1 * s, x[..., rot:]], axis=-1)


def blocks_to_seq(out):
    out = jnp.moveaxis(out, 0, 1)
    return out.reshape((out.shape[0], out.shape[1] * out.shape[2]) + out.shape[3:])


def causal_mask(start, seq_len):
    qpos = start + jnp.arange(Q_BLOCK)
    kpos = jnp.arange(seq_len)
    return kpos[None, :] <= qpos[:, None], qpos


def fox_attention(q, k, v, cum_logf):
    S = q.shape[2]
    scale = q.shape[-1] ** -0.5

    def block(i):
        start = i * Q_BLOCK
        qb = lax.dynamic_slice_in_dim(q, start, Q_BLOCK, axis=2)
        cb = lax.dynamic_slice_in_dim(cum_logf, start, Q_BLOCK, axis=2)
        logits = (jnp.einsum('bhqd,bhkd->bhqk', qb, k).astype(jnp.float32) * scale
                  + cb[..., :, None] - cum_logf[..., None, :])
        mask, _ = causal_mask(start, S)
        p = jax.nn.softmax(jnp.where(mask, logits, -jnp.inf), axis=-1).astype(v.dtype)
        return jnp.einsum('bhqk,bhkd->bqhd', p, v)

    return blocks_to_seq(lax.map(block, jnp.arange(S // Q_BLOCK)))


def diff_attention(q, k, v, lam):
    S = q.shape[3]
    scale = q.shape[-1] ** -0.5

    def block(i):
        start = i * Q_BLOCK
        qb = lax.dynamic_slice_in_dim(q, start, Q_BLOCK, axis=3)
        logits = jnp.einsum('bhmqd,bhmkd->bhmqk', qb, k).astype(jnp.float32) * scale
        mask, _ = causal_mask(start, S)
        p = jax.nn.softmax(jnp.where(mask, logits, -jnp.inf), axis=-1)
        a = (p[:, :, 0] - lam * p[:, :, 1]).astype(v.dtype)
        return jnp.einsum('bhqk,bhkd->bqhd', a, v)

    return blocks_to_seq(lax.map(block, jnp.arange(S // Q_BLOCK)))


def dsa_attention(q, k, v, q_idx, k_idx, w_idx, topk):
    S = q.shape[2]
    scale = q.shape[-1] ** -0.5
    idx_scale = q_idx.shape[-1] ** -0.5
    gather = jax.vmap(lambda table, ix: table[ix])

    def block(i):
        start = i * Q_BLOCK
        qib = lax.dynamic_slice_in_dim(q_idx, start, Q_BLOCK, axis=2)
        wib = lax.dynamic_slice_in_dim(w_idx, start, Q_BLOCK, axis=1).astype(jnp.float32)
        s_idx = jnp.einsum('bhqd,bkd->bhqk', qib, k_idx).astype(jnp.float32) * idx_scale
        score = jnp.einsum('bqh,bhqk->bqk', wib, jax.nn.relu(s_idx))
        mask, qpos = causal_mask(start, S)
        score = jnp.where(mask[None], score, -jnp.inf)
        _, sel = lax.top_k(score, topk)
        valid = sel <= qpos[None, :, None]
        kg = gather(k, sel)
        vg = gather(v, sel)
        qb = lax.dynamic_slice_in_dim(q, start, Q_BLOCK, axis=2)
        logits = jnp.einsum('bhqd,bqjd->bhqj', qb, kg).astype(jnp.float32) * scale
        p = jax.nn.softmax(jnp.where(valid[:, None], logits, -jnp.inf), axis=-1).astype(vg.dtype)
        return jnp.einsum('bhqj,bqjd->bqhd', p, vg)

    return blocks_to_seq(lax.map(block, jnp.arange(S // Q_BLOCK)))


def setup_inputs(seed: int = 0) -> dict:
    key = jax.random.key(seed)
    ks = jax.random.split(key, 19)
    f32 = jnp.float32

    def nrm(k, shape, scale):
        return jax.random.normal(k, shape, f32) * scale

    res_scale = 1.0 / math.sqrt(2 * DEPTH)
    return {
        "x": nrm(ks[0], (BATCH, SEQ, D_MODEL), 1.0),
        "attn_norm": 1.0 + nrm(ks[1], (DEPTH, D_MODEL), 0.02),
        "w_in": nrm(ks[2], (DEPTH, D_MODEL, IN_WIDTH), D_MODEL ** -0.5),
        "fox_fb": jax.random.uniform(ks[3], (DEPTH, FOX_HEADS), f32, 1.0, 4.0),
        "fox_qn": 1.0 + nrm(ks[4], (DEPTH, HEAD_DIM), 0.02),
        "fox_kn": 1.0 + nrm(ks[5], (DEPTH, HEAD_DIM), 0.02),
        "diff_qn": 1.0 + nrm(ks[6], (DEPTH, DIFF_QK_DIM), 0.02),
        "diff_kn": 1.0 + nrm(ks[7], (DEPTH, DIFF_QK_DIM), 0.02),
        "diff_lq1": nrm(ks[8], (DEPTH, DIFF_QK_DIM), 0.1),
        "diff_lk1": nrm(ks[9], (DEPTH, DIFF_QK_DIM), 0.1),
        "diff_lq2": nrm(ks[10], (DEPTH, DIFF_QK_DIM), 0.1),
        "diff_lk2": nrm(ks[11], (DEPTH, DIFF_QK_DIM), 0.1),
        "diff_subln": 1.0 + nrm(ks[12], (DEPTH, DIFF_V_DIM), 0.02),
        "dsa_qn": 1.0 + nrm(ks[13], (DEPTH, HEAD_DIM), 0.02),
        "dsa_kn": 1.0 + nrm(ks[14], (DEPTH, DSA_KV_DIM), 0.02),
        "w_out": nrm(ks[15], (DEPTH, MIX_WIDTH, D_MODEL), MIX_WIDTH ** -0.5 * res_scale),
        "ffn_norm": 1.0 + nrm(ks[16], (DEPTH, D_MODEL), 0.02),
        "w_gate_up": nrm(ks[17], (DEPTH, D_MODEL, 2 * FFN_HIDDEN), D_MODEL ** -0.5),
        "w_down": nrm(ks[18], (DEPTH, FFN_HIDDEN, D_MODEL), FFN_HIDDEN ** -0.5 * res_scale),
    }


def reference(x, attn_norm, w_in, fox_fb, fox_qn, fox_kn, diff_qn, diff_kn,
              diff_lq1, diff_lk1, diff_lq2, diff_lk2, diff_subln, dsa_qn, dsa_kn,
              w_out, ffn_norm, w_gate_up, w_down):
    B, S, _ = x.shape
    topk = min(DSA_TOPK, S // 4)
    cos64, sin64 = rope_tables(S, HEAD_DIM)
    cos32, sin32 = rope_tables(S, DIFF_QK_DIM)
    split_points = [int(v) for v in np.cumsum(SPLIT_SIZES)[:-1]]

    for l in range(DEPTH):
        h = rms_norm(x, attn_norm[l])
        proj = h @ w_in[l]
        (fq, fk, fv, ff, dq, dk, dv, sq, sk, sv, iq, ik, iw) = jnp.split(proj, split_points, axis=-1)

        fq = rms_norm(fq.reshape(B, S, FOX_HEADS, HEAD_DIM), fox_qn[l]).transpose(0, 2, 1, 3)
        fk = rms_norm(fk.reshape(B, S, FOX_HEADS, HEAD_DIM), fox_kn[l]).transpose(0, 2, 1, 3)
        fv = fv.reshape(B, S, FOX_HEADS, HEAD_DIM).transpose(0, 2, 1, 3)
        log_f = jax.nn.log_sigmoid(ff.astype(jnp.float32) + fox_fb[l].astype(jnp.float32))
        cum_logf = jnp.cumsum(log_f, axis=1).transpose(0, 2, 1)
        o_fox = fox_attention(fq, fk, fv, cum_logf).reshape(B, S, FOX_HEADS * HEAD_DIM)

        lam_init = 0.8 - 0.6 * math.exp(-0.3 * l)
        lam = (jnp.exp(jnp.sum(diff_lq1[l].astype(jnp.float32) * diff_lk1[l].astype(jnp.float32)))
               - jnp.exp(jnp.sum(diff_lq2[l].astype(jnp.float32) * diff_lk2[l].astype(jnp.float32)))
               + lam_init)
        dq = rms_norm(dq.reshape(B, S, DIFF_HEADS, 2, DIFF_QK_DIM), diff_qn[l]).transpose(0, 2, 3, 1, 4)
        dk = rms_norm(dk.reshape(B, S, DIFF_HEADS, 2, DIFF_QK_DIM), diff_kn[l]).transpose(0, 2, 3, 1, 4)
        dq = partial_rope(dq, cos32, sin32)
        dk = partial_rope(dk, cos32, sin32)
        dv = dv.reshape(B, S, DIFF_HEADS, DIFF_V_DIM).transpose(0, 2, 1, 3)
        o_diff = diff_attention(dq, dk, dv, lam)
        o_diff = (rms_norm(o_diff, diff_subln[l]) * (1.0 - lam_init)).reshape(B, S, DIFF_HEADS * DIFF_V_DIM)

        sq = partial_rope(rms_norm(sq.reshape(B, S, DSA_HEADS, HEAD_DIM), dsa_qn[l]).transpose(0, 2, 1, 3), cos64, sin64)
        sk = partial_rope(rms_norm(sk, dsa_kn[l]), cos64, sin64)
        iq = partial_rope(iq.reshape(B, S, IDX_HEADS, IDX_DIM).transpose(0, 2, 1, 3), cos64, sin64)
        ik = partial_rope(ik, cos64, sin64)
        iw = iw * (IDX_HEADS ** -0.5)
        o_dsa = dsa_attention(sq, sk, sv, iq, ik, iw, topk).reshape(B, S, DSA_HEADS * HEAD_DIM)

        x = x + jnp.concatenate([o_fox, o_diff, o_dsa], axis=-1) @ w_out[l]

        h = rms_norm(x, ffn_norm[l])
        gate, up = jnp.split(h @ w_gate_up[l], 2, axis=-1)
        x = x + (jax.nn.silu(gate) * up) @ w_down[l]
    return x
```

```cpp
#include <hip/hip_runtime.h>
#include <hip/hip_cooperative_groups.h>
#include <cstdio>
#include <cstdint>
#include <cmath>
namespace cg = cooperative_groups;
#define DUPMASK 0
namespace pg8 {
#define PG8_LAS __attribute__((address_space(3)))
typedef unsigned short bf16_t;
typedef short bf16x8 __attribute__((ext_vector_type(8)));
typedef float f32x4 __attribute__((ext_vector_type(4)));
typedef unsigned u32x4 __attribute__((ext_vector_type(4)));
constexpr int BM = 256, BK = 64, HALF = 128, HTB = HALF * BK * 2  , STAGE_BYTES = 8 * HTB, NXCD = 8, WGM = 8;

__host__ __device__ __forceinline__ int lds_byte(int r, int c) { const int st = (r >> 4) * 2 + (c >> 5), rr = r & 15, cc = c & 31, ob = rr * 64 + cc * 2; return st * 1024 + (ob ^ (((ob >> 9) & 1) << 5)); }
__host__ __device__ __forceinline__ void stage_rc(int b, int& R, int& C) { const int st = b / 1024, sb = b % 1024, swz = sb ^ (((sb >> 9) & 1) << 5); R = (st >> 1) * 16 + swz / 64; C = (st & 1) * 32 + (swz % 64) / 2; }
__host__ __device__ __forceinline__ int perm32(int rho) { const int n = rho >> 4, i = rho & 15; return 8 * (i >> 2) + 4 * n + (i & 3); }

struct Unit { int pm, pn; };
struct Gemm { const bf16_t* A; const bf16_t* Bt; int M, N, K; };

struct StaticOrder {
    int nM, nN, nwg, G, c;
    __host__ __device__ void init(int M, int N, int G_, int c_) { nM = M / BM; nN = N / BM; nwg = nM * nN; G = G_; c = c_; }
    __host__ __device__ bool next(int i, Unit& u) const {
        const long L = (long)i * G + c; if (L >= nwg) return false;
        int wgid = (int)L; { const int q = nwg / NXCD, r = nwg % NXCD, xcd = wgid % NXCD, off = wgid / NXCD; wgid = (xcd < r ? xcd * (q + 1) : r * (q + 1) + (xcd - r) * q) + off; }
        const int nig = WGM * nN, gid = wgid / nig, fm = gid * WGM, gsz = (nM - fm) < WGM ? (nM - fm) : WGM;
        u.pm = fm + ((wgid % nig) % gsz); u.pn = (wgid % nig) / gsz; return true;
    }
    __device__ __forceinline__ void a_ready(const Unit&) const {}
    __device__ __forceinline__ void done(const Unit&) const {}
};
__device__ __forceinline__ unsigned cvt_pk_bf16(float lo, float hi) { unsigned r; asm volatile("v_cvt_pk_bf16_f32 %0, %1, %2" : "=v"(r) : "v"(lo), "v"(hi)); return r; }
template <class Epi, class Sched, bool ALIGN_EPI = false, bool SP2 = false>
__device__ __forceinline__ void gemm_phase(PG8_LAS unsigned char* lds, const Gemm g, const Sched& S, const Epi& E, const int wv_in) {
    unsigned mm_ = ~0u; asm volatile("" : "+s"(mm_)); int tid_ = wv_in * 64 + (int)__builtin_amdgcn_mbcnt_hi(mm_, __builtin_amdgcn_mbcnt_lo(mm_, 0u)); asm volatile("" : "+v"(tid_)); const int tid = tid_, wid = __builtin_amdgcn_readfirstlane(tid >> 6), lane = tid & 63, wr = wid >> 2, wc = wid & 3, fr = lane & 15, fq = lane >> 4;
    const int K = g.K, nt = K / BK;
    unsigned voffA[2], voffB[2];
#pragma unroll
    for (int i = 0; i < 2; ++i) { int R, C; stage_rc(tid * 16 + i * 8192, R, C); const int Rb = Epi::PERM ? ((R & ~31) + perm32(R & 31)) : R;
        voffA[i] = (unsigned)(R * K + C) * 2u; voffB[i] = (unsigned)(Rb * K + C) * 2u; }
    const size_t kstep = (size_t)(BK * 2);
    const size_t hstep = (size_t)HALF * K * 2;
    const size_t tstep = 2 * hstep;
    const unsigned ldsw = (unsigned)wid * 1024u;
    const int aoff = lds_byte(wr * 64 + fr, fq * 8), boff = lds_byte(wc * 32 + fr, fq * 8);
#define PG8_SA(b, h) (((b) * 2 + (h)) * HTB)
#define PG8_SB(b, h) ((4 + (b) * 2 + (h)) * HTB)
#define PG8_STAGE(bufoff, gbase, voff) do { _Pragma("unroll") for (int _i = 0; _i < 2; ++_i) \
        __builtin_amdgcn_global_load_lds((const unsigned*)((const char*)(gbase) + (voff)[_i]), (PG8_LAS unsigned*)(lds + (bufoff) + ldsw + _i * 8192), 16, 0, 0); } while (0)
#define PG8_LDA(dst, b, h) do { _Pragma("unroll") for (int m = 0; m < 4; ++m) _Pragma("unroll") for (int k = 0; k < 2; ++k) dst[m][k] = *(const PG8_LAS bf16x8*)(lds + PG8_SA(b, h) + aoff + m * 2048 + k * 1024); } while (0)
#define PG8_LDB(dst, b, h) do { _Pragma("unroll") for (int n = 0; n < 2; ++n) _Pragma("unroll") for (int k = 0; k < 2; ++k) dst[n][k] = *(const PG8_LAS bf16x8*)(lds + PG8_SB(b, h) + boff + n * 2048 + k * 1024); } while (0)
#define PG8_MMA(ai, bj, At, Bt) do { __builtin_amdgcn_s_setprio(1); _Pragma("unroll") for (int m = 0; m < 4; ++m) _Pragma("unroll") for (int n = 0; n < 2; ++n) _Pragma("unroll") for (int k = 0; k < 2; ++k) \
        acc[ai][bj][m][n] = __builtin_amdgcn_mfma_f32_16x16x32_bf16(Bt[n][k], At[m][k], acc[ai][bj][m][n], 0, 0, 0); __builtin_amdgcn_s_setprio(0); } while (0)
#define PG8_WAIT_V(n) asm volatile("s_waitcnt vmcnt(" #n ")" ::: "memory")
#define PG8_WAIT_L(n) asm volatile("s_waitcnt lgkmcnt(" #n ")" ::: "memory")
#define PG8_BAR __builtin_amdgcn_s_barrier()
#define PG8_SCHED __builtin_amdgcn_sched_barrier(0)
    Unit cur, nxt; int ui = 0;
    if (!S.next(0, cur)) return;
    f32x4 acc[2][2][4][2];
#pragma unroll
    for (int a = 0; a < 2; ++a)
#pragma unroll
        for (int b = 0; b < 2; ++b)
#pragma unroll
            for (int m = 0; m < 4; ++m)
#pragma unroll
                for (int n = 0; n < 2; ++n) acc[a][b][m][n] = (f32x4){0.f, 0.f, 0.f, 0.f};
    bf16x8 At[4][2], B0[2][2], B1[2][2];
    const char* cA = (const char*)g.A + (size_t)cur.pm * tstep; const char* cB = (const char*)g.Bt + (size_t)cur.pn * tstep;
    S.a_ready(cur);
    if constexpr (SP2) {
        PG8_STAGE(PG8_SB(0, 0), cB, voffB); PG8_STAGE(PG8_SB(0, 1), cB + hstep, voffB); PG8_STAGE(PG8_SA(0, 0), cA, voffA); PG8_STAGE(PG8_SA(0, 1), cA + hstep, voffA);
        if (wr == 1) PG8_BAR;
        PG8_WAIT_V(2); PG8_BAR;
        PG8_STAGE(PG8_SB(1, 0), cB + kstep, voffB); PG8_STAGE(PG8_SA(1, 0), cA + kstep, voffA); PG8_STAGE(PG8_SB(1, 1), cB + hstep + kstep, voffB);
        PG8_WAIT_V(6); PG8_BAR;
    } else {
        PG8_STAGE(PG8_SB(0, 0), cB, voffB); PG8_STAGE(PG8_SA(0, 0), cA, voffA); PG8_STAGE(PG8_SB(0, 1), cB + hstep, voffB); PG8_STAGE(PG8_SA(0, 1), cA + hstep, voffA);
        if (wr == 1) PG8_BAR;
        PG8_WAIT_V(4); PG8_BAR;
        PG8_STAGE(PG8_SB(1, 0), cB + kstep, voffB); PG8_STAGE(PG8_SA(1, 0), cA + kstep, voffA); PG8_STAGE(PG8_SB(1, 1), cB + hstep + kstep, voffB);
        PG8_WAIT_V(6); PG8_BAR;
    }
    for (;;) {
        const bool has_next = S.next(ui + 1, nxt);
        const char* nA = has_next ? (const char*)g.A + (size_t)nxt.pm * tstep : cA; const char* nB = has_next ? (const char*)g.Bt + (size_t)nxt.pn * tstep : cB;
        for (int t = 0; t < nt; t += 2) {
            const bool last = (t == nt - 2);
            const char* a1 = cA + (size_t)(t + 1) * kstep;
            const char* a2 = last ? nA : cA + (size_t)(t + 2) * kstep; const char* b2 = last ? nB : cB + (size_t)(t + 2) * kstep;
            const char* a3 = a2 + kstep; const char* b3 = b2 + kstep;
            if (last && has_next) S.a_ready(nxt);
            if constexpr (SP2) {
            PG8_LDB(B0, 0, 0); PG8_LDB(B1, 0, 1); PG8_SCHED; PG8_LDA(At, 0, 0); PG8_STAGE(PG8_SA(1, 1), a1 + hstep, voffA);
            PG8_WAIT_V(8); PG8_WAIT_L(0); PG8_BAR; PG8_MMA(0, 0, At, B0); PG8_MMA(0, 1, At, B1); PG8_BAR; PG8_SCHED;
            PG8_LDA(At, 0, 1); PG8_STAGE(PG8_SB(0, 0), b2, voffB); PG8_STAGE(PG8_SB(0, 1), b2 + hstep, voffB); PG8_STAGE(PG8_SA(0, 0), a2, voffA);
            PG8_WAIT_V(8); PG8_WAIT_L(0); PG8_BAR; PG8_MMA(1, 0, At, B0); PG8_MMA(1, 1, At, B1); PG8_BAR; PG8_SCHED;
            PG8_LDB(B0, 1, 0); PG8_LDB(B1, 1, 1); PG8_SCHED; PG8_LDA(At, 1, 0); PG8_STAGE(PG8_SA(0, 1), a2 + hstep, voffA);
            PG8_WAIT_V(8); PG8_WAIT_L(0); PG8_BAR; PG8_MMA(0, 0, At, B0); PG8_MMA(0, 1, At, B1); PG8_BAR; PG8_SCHED;
            PG8_LDA(At, 1, 1); PG8_STAGE(PG8_SB(1, 0), b3, voffB); PG8_STAGE(PG8_SB(1, 1), b3 + hstep, voffB); PG8_STAGE(PG8_SA(1, 0), a3, voffA);
            PG8_WAIT_V(8); PG8_WAIT_L(0); PG8_BAR; PG8_MMA(1, 0, At, B0); PG8_MMA(1, 1, At, B1); PG8_BAR; PG8_SCHED;
            } else {
            PG8_LDB(B0, 0, 0); PG8_SCHED; PG8_LDA(At, 0, 0); PG8_STAGE(PG8_SA(1, 1), a1 + hstep, voffA);
            PG8_WAIT_L(8); PG8_BAR; PG8_WAIT_L(0); PG8_MMA(0, 0, At, B0); PG8_BAR; PG8_SCHED;
            PG8_LDB(B1, 0, 1); PG8_STAGE(PG8_SB(0, 0), b2, voffB);
            PG8_BAR; PG8_WAIT_L(0); PG8_MMA(0, 1, At, B1); PG8_BAR;
            PG8_LDA(At, 0, 1); PG8_STAGE(PG8_SA(0, 0), a2, voffA);
            PG8_BAR; PG8_WAIT_L(0); PG8_MMA(1, 0, At, B0); PG8_BAR; PG8_SCHED;
            PG8_STAGE(PG8_SB(0, 1), b2 + hstep, voffB);
            PG8_WAIT_V(6); PG8_BAR; PG8_MMA(1, 1, At, B1); PG8_BAR;
            PG8_LDB(B0, 1, 0); PG8_SCHED; PG8_LDA(At, 1, 0); PG8_STAGE(PG8_SA(0, 1), a2 + hstep, voffA);
            PG8_WAIT_L(8); PG8_BAR; PG8_WAIT_L(0); PG8_MMA(0, 0, At, B0); PG8_BAR; PG8_SCHED;
            PG8_LDB(B1, 1, 1); PG8_STAGE(PG8_SB(1, 0), b3, voffB);
            PG8_BAR; PG8_WAIT_L(0); PG8_MMA(0, 1, At, B1); PG8_BAR;
            PG8_LDA(At, 1, 1); PG8_STAGE(PG8_SA(1, 0), a3, voffA);
            PG8_BAR; PG8_WAIT_L(0); PG8_MMA(1, 0, At, B0); PG8_BAR; PG8_SCHED;
            PG8_STAGE(PG8_SB(1, 1), b3 + hstep, voffB);
            PG8_WAIT_V(6); PG8_BAR; PG8_MMA(1, 1, At, B1); PG8_BAR;
            }
        }
        if constexpr (ALIGN_EPI) { if (wr == 0) PG8_BAR; }
        if constexpr (!Epi::AFTER_DRAIN) { E(acc, cur, wr, wc, fr, fq); S.done(cur); }
        if (!has_next) break;
#pragma unroll
        for (int a = 0; a < 2; ++a)
#pragma unroll
            for (int b = 0; b < 2; ++b)
#pragma unroll
                for (int m = 0; m < 4; ++m)
#pragma unroll
                    for (int n = 0; n < 2; ++n) acc[a][b][m][n] = (f32x4){0.f, 0.f, 0.f, 0.f};
        cur = nxt; cA = nA; cB = nB; ++ui;
        if constexpr (ALIGN_EPI) { if (wr == 1) PG8_BAR; }
    }
    PG8_WAIT_V(0);
    if constexpr (!ALIGN_EPI) { if (wr == 0) PG8_BAR; }
    PG8_BAR;
    if constexpr (Epi::AFTER_DRAIN) { E.fused(acc, cur, wr, wc, fr, fq, lds, wid, lane); S.done(cur); }
#undef PG8_SA
#undef PG8_SB
#undef PG8_STAGE
#undef PG8_LDA
#undef PG8_LDB
#undef PG8_MMA
#undef PG8_WAIT_V
#undef PG8_WAIT_L
#undef PG8_BAR
#undef PG8_SCHED
}
}
#define LAS __attribute__((address_space(3)))
typedef unsigned short bf16_t;
typedef short bf16x8 __attribute__((ext_vector_type(8)));
typedef float f32x4 __attribute__((ext_vector_type(4)));
typedef float f32x16 __attribute__((ext_vector_type(16)));
typedef unsigned u32x4 __attribute__((ext_vector_type(4)));
typedef unsigned u32x2 __attribute__((ext_vector_type(2)));

constexpr int NB = 8, S = 2048, D = 1024, DEPTH = 4, M = NB * S;
constexpr int INW = 2762, INP = 2816, FF = 2816, GU = 5632;
constexpr int C_FQ = 0, C_FK = 384, C_FV = 768, C_DQ = 1152, C_DK = 1408, C_DV = 1664, C_SQ = 1920, C_SK = 2304, C_SV = 2368, C_IQ = 2432, C_IK = 2688, C_FF = 2752, C_IW = 2758;
constexpr float EPS = 1e-6f, LOG2E = 1.4426950408889634f, NEGBIG = -1e30f;
constexpr int NWAVES = 8, NTHR = 512;
constexpr int LDS_BYTES = 147456;
constexpr int NPH = 1 + 7 * DEPTH;

constexpr size_t MiB = 1u << 20;
constexpr size_t WS_WIN = 0, WS_WOUT = 22 * MiB, WS_WGU = 30 * MiB, WS_WDN = 74 * MiB, WS_AB = 96 * MiB, WS_PROJ = 128 * MiB,
                 WS_FQ = 216 * MiB, WS_FK = 228 * MiB, WS_DQ = 240 * MiB, WS_DK = 248 * MiB, WS_SQ = 256 * MiB, WS_SK = 268 * MiB,
                 WS_IQ = 270 * MiB, WS_IK = 278 * MiB, WS_VT = 280 * MiB, WS_SIDE = 302 * MiB, WS_LOGF = 303 * MiB, WS_MASK = 304 * MiB,
                 WS_ROPE = 308 * MiB, WS_BAR = 309 * MiB, WS_XB = 310 * MiB, WS_SSQ = 342 * MiB, WS_CTR = 344 * MiB, WS_END = 345 * MiB;

struct Args { const float* in[19]; float* out; unsigned char* ws; float invf[12]; int ph_lo, ph_hi; };

struct Ctx {
    const Args& a; int wv;
    __device__ __forceinline__ const float* in(int i) const { const float* p = a.in[i]; asm volatile("" : "+s"(p)); return p; }
    __device__ __forceinline__ float* out() const { return a.out; }
#define CTX_PTR(name, T, off) __device__ __forceinline__ T* name() const { unsigned char* w = a.ws; asm volatile("" : "+s"(w)); return (T*)(w + (off)); }
    CTX_PTR(Win, bf16_t, WS_WIN) CTX_PTR(Wout, bf16_t, WS_WOUT) CTX_PTR(Wgu, bf16_t, WS_WGU) CTX_PTR(Wdn, bf16_t, WS_WDN) CTX_PTR(AB, bf16_t, WS_AB) CTX_PTR(PROJ, bf16_t, WS_PROJ)
    CTX_PTR(FQ, bf16_t, WS_FQ) CTX_PTR(FK, bf16_t, WS_FK) CTX_PTR(DQ, bf16_t, WS_DQ) CTX_PTR(DK, bf16_t, WS_DK) CTX_PTR(SQ, bf16_t, WS_SQ) CTX_PTR(SK, bf16_t, WS_SK)
    CTX_PTR(IQ, bf16_t, WS_IQ) CTX_PTR(IK, bf16_t, WS_IK) CTX_PTR(VT, bf16_t, WS_VT) CTX_PTR(SIDE, float, WS_SIDE) CTX_PTR(LOGF, float, WS_LOGF) CTX_PTR(ROPE, float, WS_ROPE)
    CTX_PTR(MASK, unsigned, WS_MASK) CTX_PTR(XB, bf16_t, WS_XB) CTX_PTR(SSQ, float, WS_SSQ) CTX_PTR(CTR, int, WS_CTR)
#undef CTX_PTR
};

__device__ __forceinline__ unsigned f2bf(float f) { unsigned u = __builtin_bit_cast(unsigned, f); return (u + 0x7fffu + ((u >> 16) & 1u)) >> 16; }
typedef float f32x2_t __attribute__((ext_vector_type(2))); typedef __bf16 bf16x2_t __attribute__((ext_vector_type(2)));
__device__ __forceinline__ unsigned pk2(float lo, float hi) { f32x2_t v = {lo, hi}; bf16x2_t b = __builtin_convertvector(v, bf16x2_t); return __builtin_bit_cast(unsigned, b); }
__device__ __forceinline__ float bf2f(bf16_t v) { return __builtin_bit_cast(float, (unsigned)v << 16); }
__device__ __forceinline__ float wave_sum(float v) {
#pragma unroll
    for (int o = 1; o < 64; o <<= 1) v += __shfl_xor(v, o);
    return v;
}
__device__ __forceinline__ float half_sum(float v) {
#pragma unroll
    for (int o = 1; o < 32; o <<= 1) v += __shfl_xor(v, o);
    return v;
}
__device__ __forceinline__ int lane_id() { unsigned m = ~0u; asm volatile("" : "+s"(m)); return (int)__builtin_amdgcn_mbcnt_hi(m, __builtin_amdgcn_mbcnt_lo(m, 0u)); }
__device__ __forceinline__ int otid(int wv) { int t = wv * 64 + lane_id(); asm volatile("" : "+v"(t)); return t; }
__device__ __forceinline__ int crow(int r, int hi) { return (r & 3) + 8 * (r >> 2) + 4 * hi; }

__device__ __forceinline__ float row_rs(const float* ssq, int row) {
    const f32x4* p = (const f32x4*)(ssq + (size_t)row * 16); const f32x4 a = p[0], b = p[1], c = p[2], d = p[3];
    const float s = (((a[0] + a[1]) + (a[2] + a[3])) + ((b[0] + b[1]) + (b[2] + b[3]))) + (((c[0] + c[1]) + (c[2] + c[3])) + ((d[0] + d[1]) + (d[2] + d[3])));
    return 1.0f / sqrtf(s * (1.f / D) + EPS);
}
struct EpiProj {
    static constexpr bool PERM = true, AFTER_DRAIN = false;
    bf16_t* O; float* side; const float* ssq;
    __device__ __forceinline__ void operator()(const pg8::f32x4 (&acc)[2][2][4][2], const pg8::Unit& u, int wr, int wc, int fr, int fq) const {
        const int row0 = u.pm * 256 + wr * 64 + fr, col0 = u.pn * 256 + wc * 32 + 8 * fq;
#pragma unroll
        for (int ai = 0; ai < 2; ++ai)
#pragma unroll
            for (int m = 0; m < 4; ++m) { const int row = row0 + ai * 128 + m * 16; bf16_t* rowp = O + (size_t)row * INP + col0;
                const float rs = row_rs(ssq, row);
#pragma unroll
                for (int bj = 0; bj < 2; ++bj) { const f32x4 v0 = acc[ai][bj][m][0] * rs, v1 = acc[ai][bj][m][1] * rs;
                    u32x4 w; w.x = pk2(v0[0], v0[1]); w.y = pk2(v0[2], v0[3]); w.z = pk2(v1[0], v1[1]); w.w = pk2(v1[2], v1[3]);
                    *(u32x4*)(rowp + bj * 128) = w;
                    const int cc = col0 + bj * 128; float* sp = side + (size_t)row * 16;
                    if (cc == 2752) { sp[0] = v0[0]; sp[1] = v0[1]; sp[2] = v0[2]; sp[3] = v0[3]; sp[4] = v1[0]; sp[5] = v1[1]; sp[8] = v1[2]; sp[9] = v1[3]; }
                    if (cc == 2760) { sp[10] = v0[0]; sp[11] = v0[1]; } } }
    }
};
struct EpiResid {
    static constexpr bool PERM = false, AFTER_DRAIN = false;
    const float* xin; float* xout; bf16_t* xb; float* ssq;
    __device__ __forceinline__ void operator()(const pg8::f32x4 (&acc)[2][2][4][2], const pg8::Unit& u, int wr, int wc, int fr, int fq) const {
        const int col0 = u.pn * 256 + wc * 32 + 4 * fq;
#pragma unroll
        for (int ai = 0; ai < 2; ++ai)
#pragma unroll
            for (int m = 0; m < 4; ++m) { const int row = u.pm * 256 + ai * 128 + wr * 64 + m * 16 + fr; const size_t off = (size_t)row * D + col0; float sq = 0.f;
#pragma unroll
                for (int bj = 0; bj < 2; ++bj)
#pragma unroll
                    for (int n = 0; n < 2; ++n) { const f32x4 bs = *(const f32x4*)(xin + off + bj * 128 + n * 16); const f32x4 v = bs + acc[ai][bj][m][n]; *(f32x4*)(xout + off + bj * 128 + n * 16) = v;
                        if (xb) { u32x2 w; w.x = pk2(v[0], v[1]); w.y = pk2(v[2], v[3]); *(u32x2*)(xb + off + bj * 128 + n * 16) = w; sq += (v[0] * v[0] + v[1] * v[1]) + (v[2] * v[2] + v[3] * v[3]); } }
                if (xb) { sq += __shfl_xor(sq, 16); sq += __shfl_xor(sq, 32); if (fq == 0) ssq[(size_t)row * 16 + u.pn * 4 + wc] = sq; }
                if (m & 1) asm volatile("" ::: "memory"); }
    }
};
struct EpiSwiglu {
    static constexpr bool PERM = true, AFTER_DRAIN = false;
    bf16_t* H; const float* ssq;
    __device__ __forceinline__ void operator()(const pg8::f32x4 (&acc)[2][2][4][2], const pg8::Unit& u, int wr, int wc, int fr, int fq) const {
        const int row0 = u.pm * 256 + wr * 64 + fr, col0 = u.pn * 128 + wc * 32 + 8 * fq;
#pragma unroll
        for (int ai = 0; ai < 2; ++ai)
#pragma unroll
            for (int m = 0; m < 4; ++m) { const int row = row0 + ai * 128 + m * 16; float hv[8];
                const float rs = row_rs(ssq, row);
#pragma unroll
                for (int n = 0; n < 2; ++n)
#pragma unroll
                    for (int i = 0; i < 4; ++i) { const float g = acc[ai][0][m][n][i] * rs, up = acc[ai][1][m][n][i] * rs; hv[4 * n + i] = g * __builtin_amdgcn_rcpf(1.f + __expf(-g)) * up; }
                u32x4 w; w.x = pk2(hv[0], hv[1]); w.y = pk2(hv[2], hv[3]); w.z = pk2(hv[4], hv[5]); w.w = pk2(hv[6], hv[7]);
                *(u32x4*)(H + (size_t)row * FF + col0) = w; }
    }
};

__device__ __forceinline__ void wt_item(const float* __restrict__ W, int K, int Nsrc, int Ndst, const float* __restrict__ gain, bf16_t* WT, int mode, int item, LAS float* scr, int lane) {
    const int nblk = Ndst / 64, kb = item / nblk, nb = item - kb * nblk, k0 = 64 * kb, n0 = 64 * nb;
    const int nd = n0 + 2 * (lane & 31);
    int sc;
    if (mode == 1) { const int j = nd >> 8, rr = nd & 255; sc = rr < 128 ? 128 * j + rr : FF + 128 * j + (rr - 128); }
    else if (mode == 2) sc = nd < 1152 ? nd : nd < 2752 ? nd + 6 : nd < 2758 ? nd - 1600 : nd < 2762 ? nd : -1;
    else sc = nd < Nsrc ? nd : -1;
    typedef float f32x2v __attribute__((ext_vector_type(2)));
    f32x2v v[32];
#pragma unroll
    for (int i = 0; i < 32; ++i) { const int kk = 2 * i + (lane >> 5); v[i] = (f32x2v){0.f, 0.f};
        if (sc >= 0) v[i] = __builtin_nontemporal_load((const f32x2v*)(W + (size_t)(k0 + kk) * Nsrc + sc)); }
#pragma unroll
    for (int i = 0; i < 32; ++i) { const int kk = 2 * i + (lane >> 5); float g = 1.f; if (gain) g = gain[k0 + kk];
        scr[kk * 65 + 2 * (lane & 31)] = v[i].x * g; scr[kk * 65 + 2 * (lane & 31) + 1] = v[i].y * g; }
    asm volatile("s_waitcnt lgkmcnt(0)" ::: "memory");
    const int c = lane & 7;
#pragma unroll
    for (int j = 0; j < 8; ++j) { const int n = (lane >> 3) + 8 * j; const LAS float* s = scr + (8 * c) * 65 + n;
        u32x4 o; o.x = pk2(s[0 * 65], s[1 * 65]); o.y = pk2(s[2 * 65], s[3 * 65]); o.z = pk2(s[4 * 65], s[5 * 65]); o.w = pk2(s[6 * 65], s[7 * 65]);
        *(u32x4*)(WT + (size_t)(n0 + n) * K + k0 + 8 * c) = o; }
    asm volatile("s_waitcnt lgkmcnt(0)" ::: "memory");
}

__device__ __forceinline__ void convert_layer(const Ctx& c, const int l, const int gw, const int NGW, LAS float* scr, const int lane) {
    constexpr int I_IN = 16 * (INP / 64), I_OUT = 16 * (D / 64), I_GU = 16 * (GU / 64), I_DN = (FF / 64) * (D / 64), I_L = I_IN + I_OUT + I_GU + I_DN;
#pragma unroll 1
    for (int it = gw; it < I_L; it += NGW) {
        int r = it;
        if (r < I_IN) { wt_item(c.in(2) + (size_t)l * D * INW, D, INW, INP, c.in(1) + l * D, c.Win() + (size_t)l * INP * D, 2, r, scr, lane); continue; } r -= I_IN;
        if (r < I_OUT) { wt_item(c.in(15) + (size_t)l * D * D, D, D, D, nullptr, c.Wout() + (size_t)l * D * D, 0, r, scr, lane); continue; } r -= I_OUT;
        if (r < I_GU) { wt_item(c.in(17) + (size_t)l * D * GU, D, GU, GU, c.in(16) + l * D, c.Wgu() + (size_t)l * GU * D, 1, r, scr, lane); continue; } r -= I_GU;
        wt_item(c.in(18) + (size_t)l * FF * D, FF, D, D, nullptr, c.Wdn() + (size_t)l * D * FF, 0, r, scr, lane);
    }
}

__device__ __forceinline__ void phase0(const Ctx& c, const Args& a, LAS unsigned char* L) {
    const int tid = otid(c.wv), lane = tid & 63, wave = tid >> 6;
    LAS float* scr = (LAS float*)(L + wave * 16640);
    const int gw = blockIdx.x * NWAVES + wave, NGW = gridDim.x * NWAVES;
    for (int l = 0; l < (gridDim.x == 256 ? 1 : DEPTH); ++l) convert_layer(c, l, gw, NGW, scr, lane);
    { float* ssq = c.SSQ(); bf16_t* xb = c.XB(); const float* x = c.in(0);
      for (int m = gw; m < M; m += NGW) {
        const f32x4* xr = (const f32x4*)(x + (size_t)m * D) + lane;
        f32x4 v[4]; float ss = 0.f;
#pragma unroll
        for (int j = 0; j < 4; ++j) { v[j] = xr[64 * j]; ss += (v[j].x * v[j].x + v[j].y * v[j].y) + (v[j].z * v[j].z + v[j].w * v[j].w); }
        ss = wave_sum(ss);
        u32x2* o8 = (u32x2*)(xb + (size_t)m * D) + lane;
#pragma unroll
        for (int j = 0; j < 4; ++j) { u32x2 w; w.x = pk2(v[j].x, v[j].y); w.y = pk2(v[j].z, v[j].w); o8[64 * j] = w; }
        if (lane < 16) ssq[(size_t)m * 16 + lane] = lane == 0 ? ss : 0.f;
      } }
    if (blockIdx.x == 0 && tid < DEPTH) c.CTR()[64 * tid] = 0;
    const int gt = blockIdx.x * NTHR + tid, NGT = gridDim.x * NTHR;
    for (int e = gt; e < S * 12; e += NGT) {
        const int s = e / 12, i = e - s * 12;
        const float angf = (float)s * a.invf[i];
        const double ang = (double)angf;
        const double k = __builtin_rint(ang * 0.63661977236758134308);
        const double r = __builtin_fma(-k, 1.57079632679489661923, ang) - k * 6.123233995736766e-17;
        const double r2 = r * r;
        double sn = -1.0 / 6227020800.0; sn = sn * r2 + 1.0 / 39916800.0; sn = sn * r2 - 1.0 / 362880.0; sn = sn * r2 + 1.0 / 5040.0; sn = sn * r2 - 1.0 / 120.0; sn = sn * r2 + 1.0 / 6.0; sn = r - r * r2 * sn;
        double cs = 1.0 / 87178291200.0; cs = cs * r2 - 1.0 / 479001600.0; cs = cs * r2 + 1.0 / 3628800.0; cs = cs * r2 - 1.0 / 40320.0; cs = cs * r2 + 1.0 / 720.0; cs = cs * r2 - 1.0 / 24.0; cs = cs * r2 + 0.5; cs = 1.0 - r2 * cs;
        const int q = ((int)k) & 3;
        const double cv = (q == 0) ? cs : (q == 1) ? -sn : (q == 2) ? -cs : sn;
        const double sv = (q == 0) ? sn : (q == 1) ? cs : (q == 2) ? -sn : -cs;
        c.ROPE()[2 * e] = (float)cv; c.ROPE()[2 * e + 1] = (float)sv;
    }
}

__device__ __forceinline__ void norm_phase(const Ctx& c, const float* x, bf16_t* xn) {
    const int tid = otid(c.wv), lane = tid & 63, wave = tid >> 6;
    const int gw = blockIdx.x * NWAVES + wave, NGW = gridDim.x * NWAVES;
    for (int m = gw; m < M; m += NGW) {
        const f32x4* xr = (const f32x4*)(x + (size_t)m * D) + lane;
        f32x4 v[4]; float ss = 0.f;
#pragma unroll
        for (int j = 0; j < 4; ++j) { v[j] = xr[64 * j]; ss += (v[j].x * v[j].x + v[j].y * v[j].y) + (v[j].z * v[j].z + v[j].w * v[j].w); }
        const float r = 1.0f / sqrtf(wave_sum(ss) * (1.f / D) + EPS);
        u32x2* o8 = (u32x2*)(xn + (size_t)m * D) + lane;
#pragma unroll
        for (int j = 0; j < 4; ++j) { u32x2 w; w.x = pk2(v[j].x * r, v[j].y * r); w.y = pk2(v[j].z * r, v[j].w * r); o8[64 * j] = w; }
    }
}

template <int KIND>
__device__ __forceinline__ void prep_kind(const Ctx& c, int l, int gw, int NGW, int lane) {
    constexpr int NSLOT = KIND == 0 ? 12 : KIND == 1 ? 8 : KIND == 2 ? 7 : 5, NQ = KIND == 0 ? 6 : KIND == 1 ? 4 : KIND == 2 ? 6 : 4;
    constexpr int UNR = 4, NRT = KIND == 1 ? 2 : KIND >= 2 ? 4 : 1;
    const int sub = lane & 7;
    const float QS64 = 0.125f * LOG2E, QS32 = 0.17677669529663687f * LOG2E;
    const bf16_t* proj = c.PROJ(); const float* rope = c.ROPE();
    f32x4 gq0 = {1.f, 1.f, 1.f, 1.f}, gq1 = gq0, gk0 = gq0, gk1 = gq0;
    if (KIND != 3) { const float* gq = (KIND == 0 ? c.in(4) + l * 64 : KIND == 1 ? c.in(6) + l * 32 : c.in(13) + l * 64) + (KIND == 1 ? 8 * (sub & 3) : 8 * sub);
        const float* gk = (KIND == 0 ? c.in(5) + l * 64 : KIND == 1 ? c.in(7) + l * 32 : c.in(14) + l * 64) + (KIND == 1 ? 8 * (sub & 3) : 8 * sub);
        gq0 = *(const f32x4*)gq; gq1 = *(const f32x4*)(gq + 4); gk0 = *(const f32x4*)gk; gk1 = *(const f32x4*)(gk + 4); }
    for (int it0 = gw * 8; it0 < M * NSLOT; it0 += NGW * 8 * UNR) {
        u32x4 raw[UNR]; f32x4 rt[UNR][NRT];
#pragma unroll
        for (int u = 0; u < UNR; ++u) if (it0 + u * NGW * 8 < M * NSLOT) {
            const int it = it0 + u * NGW * 8 + (lane >> 3), m = it / NSLOT, j = it - m * NSLOT, s = m % S;
            const int scol = KIND == 0 ? (j < 6 ? C_FQ + 64 * j : C_FK + 64 * (j - 6)) : KIND == 1 ? (j < 4 ? C_DQ + 64 * j : C_DK + 64 * (j - 4)) : KIND == 2 ? (j < 6 ? C_SQ + 64 * j : C_SK) : (j < 4 ? C_IQ + 64 * j : C_IK);
            raw[u] = __builtin_nontemporal_load((const u32x4*)(proj + (size_t)m * INP + scol + 8 * sub));
            if (KIND == 1) { rt[u][0] = *(const f32x4*)(rope + (size_t)s * 24 + 16); rt[u][NRT - 1] = *(const f32x4*)(rope + (size_t)s * 24 + 20); }
            if (KIND >= 2) {
#pragma unroll
                for (int q = 0; q < NRT; ++q) rt[u][q] = *(const f32x4*)(rope + (size_t)s * 24 + 4 * q); }
        }
#pragma unroll
        for (int u = 0; u < UNR; ++u) if (it0 + u * NGW * 8 < M * NSLOT) {
            const int it = it0 + u * NGW * 8 + (lane >> 3), m = it / NSLOT, j = it - m * NSLOT, b = m / S, s = m % S;
            bf16_t* dst; float qs = 1.f;
            if (KIND == 0) { if (j < 6) { dst = c.FQ() + ((size_t)(b * 6 + j) * S + s) * 64; qs = QS64; } else dst = c.FK() + ((size_t)(b * 6 + j - 6) * S + s) * 64; }
            else if (KIND == 1) { if (j < 4) { dst = c.DQ() + ((size_t)(b * 4 + j) * S + s) * 64; qs = QS32; } else dst = c.DK() + ((size_t)(b * 4 + j - 4) * S + s) * 64; }
            else if (KIND == 2) { if (j < 6) { dst = c.SQ() + ((size_t)(b * 6 + j) * S + s) * 64; qs = QS64; } else dst = c.SK() + (size_t)m * 64; }
            else { if (j < 4) dst = c.IQ() + (size_t)m * 256 + 64 * j; else dst = c.IK() + (size_t)m * 64; }
            float v[8];
#pragma unroll
            for (int i = 0; i < 4; ++i) { v[2 * i] = __builtin_bit_cast(float, raw[u][i] << 16); v[2 * i + 1] = __builtin_bit_cast(float, raw[u][i] & 0xffff0000u); }
            if (KIND != 3) {
                float ss = 0.f;
#pragma unroll
                for (int i = 0; i < 8; ++i) ss += v[i] * v[i];
                ss += __shfl_xor(ss, 1); ss += __shfl_xor(ss, 2); if (KIND != 1) ss += __shfl_xor(ss, 4);
                const float r = 1.0f / sqrtf(ss * (KIND == 1 ? 1.f / 32.f : 1.f / 64.f) + EPS);
                const f32x4 g0 = j < NQ ? gq0 : gk0, g1 = j < NQ ? gq1 : gk1;
#pragma unroll
                for (int i = 0; i < 4; ++i) { v[i] *= r * g0[i]; v[4 + i] *= r * g1[i]; }
            }
            if (KIND == 1) {
                if ((sub & 3) == 0) { const f32x4 t0 = rt[u][0], t1 = rt[u][NRT - 1];
                    const float cs[4] = {t0[0], t0[2], t1[0], t1[2]}, sn[4] = {t0[1], t0[3], t1[1], t1[3]};
#pragma unroll
                    for (int i = 0; i < 4; ++i) { const float x1 = v[i], x2 = v[4 + i]; v[i] = x1 * cs[i] - x2 * sn[i]; v[4 + i] = x2 * cs[i] + x1 * sn[i]; } }
            } else if (KIND >= 2) {
                float p[8];
#pragma unroll
                for (int i = 0; i < 8; ++i) p[i] = __shfl_xor(v[i], 1);
                if (sub < 2) { const float sg = sub == 0 ? -1.f : 1.f;
#pragma unroll
                    for (int q = 0; q < 4; ++q) { const f32x4 t = rt[u][q < NRT ? q : 0];
                        v[2 * q] = v[2 * q] * t[0] + sg * p[2 * q] * t[1]; v[2 * q + 1] = v[2 * q + 1] * t[2] + sg * p[2 * q + 1] * t[3]; } }
            }
            u32x4 w; w.x = pk2(v[0] * qs, v[1] * qs); w.y = pk2(v[2] * qs, v[3] * qs); w.z = pk2(v[4] * qs, v[5] * qs); w.w = pk2(v[6] * qs, v[7] * qs);
            *(u32x4*)(dst + 8 * sub) = w;
        }
    }
}
__device__ __forceinline__ void prep_phase(const Ctx& c, int l, LAS unsigned char* L) {
    const int tid = otid(c.wv), lane = tid & 63, wave = tid >> 6;
    const int gw = blockIdx.x * NWAVES + wave, NGW = gridDim.x * NWAVES;
    prep_kind<0>(c, l, gw, NGW, lane);
    prep_kind<1>(c, l, gw, NGW, lane);
    prep_kind<2>(c, l, gw, NGW, lane);
    prep_kind<3>(c, l, gw, NGW, lane);
    for (int e = blockIdx.x * NTHR + tid; e < NB * 6 * S; e += gridDim.x * NTHR) {
        const int s = e % S, h = (e / S) % 6, b = e / (6 * S);
        const float z = c.SIDE()[(size_t)(b * S + s) * 16 + h] + c.in(3)[l * 6 + h];
        c.LOGF()[e] = fminf(z, 0.f) - log1pf(__expf(-fabsf(z)));
    }
    LAS unsigned char* T = L + wave * 8704;
    for (int it = gw; it < NB * 11 * (S / 64); it += NGW) {
        const int blk = it % (S / 64), slot = (it / (S / 64)) % 11, b = it / (11 * (S / 64));
        const int vcol = slot < 6 ? C_FV + 64 * slot : slot < 10 ? C_DV + 64 * (slot - 6) : C_SV;
        const bf16_t* src = c.PROJ() + ((size_t)(b * S + 64 * blk)) * INP + vcol + 8 * (lane & 7);
        u32x4 rv[8];
#pragma unroll
        for (int i = 0; i < 8; ++i) rv[i] = __builtin_nontemporal_load((const u32x4*)(src + (size_t)(8 * i + (lane >> 3)) * INP));
#pragma unroll
        for (int i = 0; i < 8; ++i) { LAS u32x2* tp = (LAS u32x2*)(T + (8 * i + (lane >> 3)) * 136 + 16 * (lane & 7)); u32x2 a0; a0.x = rv[i].x; a0.y = rv[i].y; u32x2 a1; a1.x = rv[i].z; a1.y = rv[i].w; tp[0] = a0; tp[1] = a1; }
        asm volatile("s_waitcnt lgkmcnt(0)" ::: "memory");
        unsigned o[32];
#pragma unroll
        for (int i = 0; i < 32; ++i) o[i] = 0u;
#pragma unroll
        for (int kv = 0; kv < 64; ++kv) { const int pos = (kv & 32) + 16 * ((kv >> 2) & 1) + (kv & 3) + 4 * ((kv & 31) >> 3);
            const unsigned v = *(const LAS bf16_t*)(T + kv * 136 + 2 * lane); o[pos >> 1] |= v << (16 * (pos & 1)); }
        u32x4* dstp = (u32x4*)(c.VT() + ((size_t)(b * 11 + slot) * 64 + lane) * S + 64 * blk);
#pragma unroll
        for (int q = 0; q < 8; ++q) { u32x4 w; w.x = o[4 * q]; w.y = o[4 * q + 1]; w.z = o[4 * q + 2]; w.w = o[4 * q + 3]; dstp[q] = w; }
        asm volatile("s_waitcnt lgkmcnt(0)" ::: "memory");
    }
}

constexpr int SC_PITCH = 2052;
__device__ __forceinline__ unsigned f2key(float v) { const unsigned u = __builtin_bit_cast(unsigned, v); return (u & 0x80000000u) ? ~u : (u | 0x80000000u); }
__device__ __forceinline__ unsigned wave_max_u(unsigned v) {
#pragma unroll
    for (int o = 1; o < 64; o <<= 1) { const unsigned n = (unsigned)__shfl_xor((int)v, o); v = n > v ? n : v; }
    return v;
}
__device__ __forceinline__ unsigned wave_min_u(unsigned v) {
#pragma unroll
    for (int o = 1; o < 64; o <<= 1) { const unsigned n = (unsigned)__shfl_xor((int)v, o); v = n < v ? n : v; }
    return v;
}
__device__ __forceinline__ unsigned wave_sum_u(unsigned v) {
    v += (unsigned)__builtin_amdgcn_update_dpp(0, (int)v, 0xB1, 0xf, 0xf, true);
    v += (unsigned)__builtin_amdgcn_update_dpp(0, (int)v, 0x4E, 0xf, 0xf, true);
    v += (unsigned)__builtin_amdgcn_update_dpp(0, (int)v, 0x141, 0xf, 0xf, true);
    v += (unsigned)__builtin_amdgcn_update_dpp(0, (int)v, 0x140, 0xf, 0xf, true);
    return (unsigned)__builtin_amdgcn_readlane((int)v, 0) + (unsigned)__builtin_amdgcn_readlane((int)v, 16) + (unsigned)__builtin_amdgcn_readlane((int)v, 32) + (unsigned)__builtin_amdgcn_readlane((int)v, 48);
}
__device__ __forceinline__ void idx_unit(const Ctx& c, int b, int blk, LAS unsigned char* L) {
    const int tid = otid(c.wv), lane = tid & 63, wave = __builtin_amdgcn_readfirstlane(tid >> 6), q = lane & 15, quad = lane >> 4;
    const int t0 = 16 * blk;
    LAS float* SC = (LAS float*)L;
    {
        const bf16_t* iqp = c.IQ() + (size_t)(b * S + t0 + q) * 256 + 8 * quad;
        bf16x8 bq[4][2];
#pragma unroll
        for (int h = 0; h < 4; ++h)
#pragma unroll
            for (int ks = 0; ks < 2; ++ks) bq[h][ks] = *(const bf16x8*)(iqp + 64 * h + 32 * ks);
        const f32x4 w = *(const f32x4*)(c.SIDE() + (size_t)(b * S + t0 + q) * 16 + 8);
        const bf16_t* ikb = c.IK() + (size_t)(b * S + q) * 64 + 8 * quad;
#pragma unroll 1
        for (int tb = 4 * wave; tb <= blk; tb += 4 * NWAVES) {
            bf16x8 a0[4], a1[4];
#pragma unroll
            for (int u = 0; u < 4; ++u) { const int tile = tb + u <= blk ? tb + u : blk; const bf16_t* ikp = ikb + (size_t)tile * 1024; a0[u] = *(const bf16x8*)ikp; a1[u] = *(const bf16x8*)(ikp + 32); }
#pragma unroll
            for (int u = 0; u < 4; ++u) if (tb + u <= blk) {
                f32x4 sc = {0.f, 0.f, 0.f, 0.f};
#pragma unroll
                for (int h = 0; h < 4; ++h) { f32x4 acc = {0.f, 0.f, 0.f, 0.f};
                    acc = __builtin_amdgcn_mfma_f32_16x16x32_bf16(a0[u], bq[h][0], acc, 0, 0, 0);
                    acc = __builtin_amdgcn_mfma_f32_16x16x32_bf16(a1[u], bq[h][1], acc, 0, 0, 0);
#pragma unroll
                    for (int r = 0; r < 4; ++r) sc[r] += w[h] * fmaxf(acc[r], 0.f); }
                *(LAS f32x4*)(SC + q * SC_PITCH + 16 * (tb + u) + 4 * quad) = sc;
            }
        }
    }
    __syncthreads();
#pragma unroll 1
    for (int rr = 0; rr < 2; ++rr) {
        const int row = 2 * wave + rr, t = t0 + row;
        const LAS float* srow = SC + row * SC_PITCH;
        unsigned key[32];
#pragma unroll
        for (int j = 0; j < 32; ++j) key[j] = __builtin_bit_cast(unsigned, srow[64 * j + lane]);
#pragma unroll
        for (int j = 0; j < 32; ++j) { const unsigned k = f2key(__builtin_bit_cast(float, key[j]) + 0.0f); key[j] = (64 * j + lane <= t) ? k : 0u; }
        unsigned W = 0u;
        if (t + 1 > 256) {
            unsigned kmx = 0u, kmn = 0xffffffffu;
#pragma unroll
            for (int j = 0; j < 32; ++j) { kmx = key[j] > kmx ? key[j] : kmx; const unsigned kk = key[j] ? key[j] : 0xffffffffu; kmn = kk < kmn ? kk : kmn; }
            unsigned lo, hi, cge;
            {
            lo = __builtin_amdgcn_readfirstlane(wave_min_u(kmn)); hi = __builtin_amdgcn_readfirstlane(wave_max_u(kmx)) + 1u; cge = 0xffffffffu; asm volatile("" : "+v"(kmn), "+v"(kmx));
            while (hi - lo > 1u) {
                const unsigned mid = lo + ((hi - lo) >> 1);
                unsigned c0 = 0u, c1 = 0u, c2 = 0u, c3 = 0u;
#pragma unroll
                for (int j = 0; j < 32; j += 4) { unsigned long long m0, m1, m2, m3;
                    asm("v_cmp_ge_u32_e64 %4, %8, %12\n\tv_cmp_ge_u32_e64 %5, %9, %12\n\tv_cmp_ge_u32_e64 %6, %10, %12\n\tv_cmp_ge_u32_e64 %7, %11, %12\n\t"
                        "v_addc_co_u32_e64 %0, %4, %0, 0, %4\n\tv_addc_co_u32_e64 %1, %5, %1, 0, %5\n\tv_addc_co_u32_e64 %2, %6, %2, 0, %6\n\tv_addc_co_u32_e64 %3, %7, %3, 0, %7"
                        : "+v"(c0), "+v"(c1), "+v"(c2), "+v"(c3), "=&s"(m0), "=&s"(m1), "=&s"(m2), "=&s"(m3)
                        : "v"(key[j]), "v"(key[j + 1]), "v"(key[j + 2]), "v"(key[j + 3]), "s"(mid)); }
                const unsigned cnt = wave_sum_u((c0 + c1) + (c2 + c3));
                if (cnt >= 256u) { lo = mid; cge = cnt; if (cnt == 256u) break; } else hi = mid;
            }
            }
            const unsigned T = lo;
            if (cge == 256u) {
#pragma unroll
                for (int j = 31; j >= 0; --j) W = (W << 1) | ((key[j] >= T) ? 1u : 0u);
            } else {
                unsigned cl = 0u;
#pragma unroll
                for (int j = 0; j < 32; ++j) cl += (key[j] > T) ? 1u : 0u;
                const unsigned need = 256u - wave_sum_u(cl);
                unsigned running = 0u; const unsigned long long ltmask = (1ull << lane) - 1ull;
#pragma unroll
                for (int j = 0; j < 32; ++j) { const unsigned long long eq = __ballot(key[j] == T);
                    const unsigned rank = running + (unsigned)__popcll(eq & ltmask);
                    const bool take = key[j] > T || (key[j] == T && rank < need);
                    running += (unsigned)__popcll(eq);
                    W |= (take ? 1u : 0u) << j; }
            }
        } else {
#pragma unroll
            for (int j = 0; j < 32; ++j) W |= (key[j] != 0u ? 1u : 0u) << j;
        }
        c.MASK()[(size_t)(b * S + t) * 64 + lane] = W;
    }
    __syncthreads();
}

constexpr int AT_KB0 = 0, AT_KB1 = 18432, AT_VB0 = 36864, AT_VB1 = 54272, AT_CUM = 71680, AT_SCR = 79872;
constexpr int AT_KP = 144, AT_VP = 272;
template <int TYPE>
__device__ __forceinline__ void att_qk(f32x16 (&p)[2], const LAS unsigned char* Kb, const LAS float* CUM, const int j, const int sub, const int mp, const int r32, const int hi, const float cq, const bf16x8 (&qr)[4]) {
    constexpr int NMAP = TYPE == 1 ? 2 : 1, KS = 4 / NMAP;
    if (TYPE == 0) {
#pragma unroll
        for (int g = 0; g < 4; ++g) { const f32x4 c0 = *(const LAS f32x4*)(CUM + 64 * j + 8 * g + 4 * hi), c1 = *(const LAS f32x4*)(CUM + 64 * j + 32 + 8 * g + 4 * hi);
#pragma unroll
            for (int i = 0; i < 4; ++i) { p[0][4 * g + i] = cq - c0[i]; p[1][4 * g + i] = cq - c1[i]; } }
    } else {
#pragma unroll
        for (int r = 0; r < 16; ++r) { p[0][r] = 0.f; p[1][r] = 0.f; }
    }
#pragma unroll
    for (int ks = 0; ks < KS; ++ks) { const int d0 = mp * KS + ks;
        const bf16x8 a0 = *(const LAS bf16x8*)(Kb + (sub * 64 + r32) * AT_KP + d0 * 32 + hi * 16);
        const bf16x8 a1 = *(const LAS bf16x8*)(Kb + (sub * 64 + 32 + r32) * AT_KP + d0 * 32 + hi * 16);
        p[0] = __builtin_amdgcn_mfma_f32_32x32x16_bf16(a0, qr[d0], p[0], 0, 0, 0);
        p[1] = __builtin_amdgcn_mfma_f32_32x32x16_bf16(a1, qr[d0], p[1], 0, 0, 0); }
}
template <int TYPE, bool BAND>
__device__ __forceinline__ void att_sm(f32x16 (&p)[2], u32x4 (&pw)[2][2], float& lr, const int j, const int qb, const int tq, const int hi, const u32x4 (&mk0)[4], const u32x4 (&mk1)[4]) {
    if (TYPE != 2) {
        if (BAND) { const int jb = j - 4 * qb;
            if (jb >= 0) { const int base = tq - 64 * j - 4 * hi;
#pragma unroll
                for (int r = 0; r < 16; ++r) { const int kk = (r & 3) + 8 * (r >> 2); if (kk > base) p[0][r] = NEGBIG; if (kk + 32 > base) p[1][r] = NEGBIG; } } }
    } else {
        const unsigned bitj = 1u << j;
#pragma unroll
        for (int r = 0; r < 16; ++r) { if (!(mk0[r >> 2][r & 3] & bitj)) p[0][r] = NEGBIG; if (!(mk1[r >> 2][r & 3] & bitj)) p[1][r] = NEGBIG; }
    }
    float ls = 0.f;
#pragma unroll
    for (int r = 0; r < 16; ++r) { p[0][r] = __builtin_amdgcn_exp2f(p[0][r]); p[1][r] = __builtin_amdgcn_exp2f(p[1][r]); ls += p[0][r] + p[1][r]; }
    lr += ls;
#pragma unroll
    for (int pp = 0; pp < 2; ++pp)
#pragma unroll
        for (int cc = 0; cc < 2; ++cc) { u32x4 w;
            w.x = pk2(p[pp][8 * cc + 0], p[pp][8 * cc + 1]); w.y = pk2(p[pp][8 * cc + 2], p[pp][8 * cc + 3]);
            w.z = pk2(p[pp][8 * cc + 4], p[pp][8 * cc + 5]); w.w = pk2(p[pp][8 * cc + 6], p[pp][8 * cc + 7]); pw[pp][cc] = w; }
}
__device__ __forceinline__ void att_pv(f32x16 (&o)[2], const u32x4 (&pw)[2][2], const LAS unsigned char* Vb, const int sub, const int r32, const int hi) {
#pragma unroll
    for (int pp = 0; pp < 2; ++pp)
#pragma unroll
        for (int cc = 0; cc < 2; ++cc)
#pragma unroll
            for (int db = 0; db < 2; ++db) {
                const bf16x8 av = *(const LAS bf16x8*)(Vb + (32 * db + r32) * AT_VP + sub * 128 + pp * 64 + hi * 32 + cc * 16);
                o[db] = __builtin_amdgcn_mfma_f32_32x32x16_bf16(av, __builtin_bit_cast(bf16x8, pw[pp][cc]), o[db], 0, 0, 0); }
}
template <int TYPE, bool BAND>
__device__ __forceinline__ void att_step(const LAS unsigned char* Kb, const LAS unsigned char* Vb, const LAS float* CUM, const int jj, const int qb, const int wave, const int tq, const int r32, const int hi,
                                         const float cq, const bf16x8 (&qr)[4], const u32x4 (&mk0)[4], const u32x4 (&mk1)[4], float (&lrun)[TYPE == 1 ? 2 : 1], f32x16 (&o)[TYPE == 1 ? 2 : 1][2]) {
    constexpr int NMAP = TYPE == 1 ? 2 : 1;
#pragma unroll
    for (int mp = 0; mp < NMAP; ++mp) {
        if (!BAND && TYPE == 0) {
            f32x16 pA[2], pB[2]; u32x4 wA[2][2], wB[2][2];
            att_qk<TYPE>(pA, Kb, CUM, 2 * jj, 0, mp, r32, hi, cq, qr);
            __builtin_amdgcn_sched_barrier(0);
            att_qk<TYPE>(pB, Kb, CUM, 2 * jj + 1, 1, mp, r32, hi, cq, qr);
            att_sm<TYPE, false>(pA, wA, lrun[mp], 2 * jj, qb, tq, hi, mk0, mk1);
            __builtin_amdgcn_sched_barrier(0);
            att_pv(o[mp], wA, Vb, 0, r32, hi);
            att_sm<TYPE, false>(pB, wB, lrun[mp], 2 * jj + 1, qb, tq, hi, mk0, mk1);
            __builtin_amdgcn_sched_barrier(0);
            att_pv(o[mp], wB, Vb, 1, r32, hi);
            __builtin_amdgcn_sched_barrier(0);
        } else {
#pragma unroll
            for (int sub = 0; sub < 2; ++sub) { const int j = 2 * jj + sub, jb = j - 4 * qb;
                const bool skip = BAND && (jb >= 0) && (64 * jb > 32 * wave + 31);
                if (!skip) { f32x16 pA[2]; u32x4 wA[2][2];
                    att_qk<TYPE>(pA, Kb, CUM, j, sub, mp, r32, hi, cq, qr);
                    att_sm<TYPE, BAND>(pA, wA, lrun[mp], j, qb, tq, hi, mk0, mk1);
                    att_pv(o[mp], wA, Vb, sub, r32, hi); }
                __builtin_amdgcn_sched_barrier(0); }
        }
    }
}

template <int TYPE>
__device__ __forceinline__ void attn_unit(const Ctx& c, int l, int b, int h, int qb, LAS unsigned char* L) {
    constexpr int NMAP = TYPE == 1 ? 2 : 1;
    const int tid = otid(c.wv), lane = tid & 63, wave = __builtin_amdgcn_readfirstlane(tid >> 6), r32 = lane & 31, hi = lane >> 5;
    const bf16_t *Qp, *Kp, *Vp; int ocol;
    if (TYPE == 0) { Qp = c.FQ() + (size_t)(b * 6 + h) * S * 64; Kp = c.FK() + (size_t)(b * 6 + h) * S * 64; Vp = c.VT() + (size_t)(b * 11 + h) * 64 * S; ocol = 64 * h; }
    else if (TYPE == 1) { Qp = c.DQ() + (size_t)(b * 4 + h) * S * 64; Kp = c.DK() + (size_t)(b * 4 + h) * S * 64; Vp = c.VT() + (size_t)(b * 11 + 6 + h) * 64 * S; ocol = 384 + 64 * h; }
    else { Qp = c.SQ() + (size_t)(b * 6 + h) * S * 64; Kp = c.SK() + (size_t)b * S * 64; Vp = c.VT() + (size_t)(b * 11 + 10) * 64 * S; ocol = 640 + 64 * h; }
    const int q0 = 256 * qb, tq = q0 + 32 * wave + r32, ns = 2 * (qb + 1);
    const bf16_t* kg0 = Kp + (size_t)(tid >> 3) * 64 + (tid & 7) * 8;
    const bf16_t* vg0 = Vp + (size_t)(tid >> 4) * S + (tid & 15) * 8;
    const unsigned ksoff = (tid >> 3) * AT_KP + (tid & 7) * 16, vsoff = (tid >> 4) * AT_VP + (tid & 15) * 16;
    u32x4 kreg[2], vreg[2];
    kreg[0] = *(const u32x4*)kg0; kreg[1] = *(const u32x4*)(kg0 + 64 * 64); vreg[0] = *(const u32x4*)vg0; vreg[1] = *(const u32x4*)(vg0 + (size_t)32 * S);
    bf16x8 qr[4];
#pragma unroll
    for (int d0 = 0; d0 < 4; ++d0) qr[d0] = *(const bf16x8*)(Qp + (size_t)tq * 64 + d0 * 16 + hi * 8);
    u32x4 mk0[4], mk1[4];
#pragma unroll
    for (int g = 0; g < 4; ++g) { mk0[g] = (u32x4){0u, 0u, 0u, 0u}; mk1[g] = (u32x4){0u, 0u, 0u, 0u}; }
    if (TYPE == 2) { const unsigned* mrow = c.MASK() + (size_t)(b * S + tq) * 64 + 4 * hi;
#pragma unroll
        for (int g = 0; g < 4; ++g) { mk0[g] = *(const u32x4*)(mrow + 8 * g); mk1[g] = *(const u32x4*)(mrow + 32 + 8 * g); } }
    LAS float* CUM = (LAS float*)(L + AT_CUM);
    if (TYPE == 0) {
        LAS float* SCR = (LAS float*)(L + AT_SCR);
        const f32x4 lf = *(const f32x4*)(c.LOGF() + (size_t)(b * 6 + h) * S + 4 * tid);
        const float a0 = lf[0], a1 = a0 + lf[1], a2 = a1 + lf[2], a3 = a2 + lf[3];
        float incl = a3;
#pragma unroll 1
        for (int off = 1; off < 64; off <<= 1) { const float n = __shfl_up(incl, off); if (lane >= off) incl += n; }
        if (lane == 63) SCR[wave] = incl;
        __syncthreads();
        float base = 0.f;
#pragma unroll
        for (int w = 0; w < NWAVES; ++w) if (w < wave) base += SCR[w];
        const float ex = incl - a3 + base;
        f32x4 cv; cv[0] = (ex + a0) * LOG2E; cv[1] = (ex + a1) * LOG2E; cv[2] = (ex + a2) * LOG2E; cv[3] = (ex + a3) * LOG2E;
        *(LAS f32x4*)(CUM + 4 * tid) = cv;
    }
    *(LAS u32x4*)(L + AT_KB0 + ksoff) = kreg[0]; *(LAS u32x4*)(L + AT_KB0 + ksoff + 64 * AT_KP) = kreg[1];
    *(LAS u32x4*)(L + AT_VB0 + vsoff) = vreg[0]; *(LAS u32x4*)(L + AT_VB0 + vsoff + 32 * AT_VP) = vreg[1];
    __syncthreads();
    float cq = 0.f; if (TYPE == 0) cq = CUM[tq];
    float lrun[NMAP]; f32x16 o[NMAP][2];
#pragma unroll
    for (int mp = 0; mp < NMAP; ++mp) { lrun[mp] = 0.f;
#pragma unroll
        for (int r = 0; r < 16; ++r) { o[mp][0][r] = 0.f; o[mp][1][r] = 0.f; } }
#pragma unroll 1
    for (int jj = 0; jj < ns; ++jj) {
        const int cur = jj & 1;
        if (jj + 1 < ns) { const bf16_t* kg = kg0 + (size_t)(jj + 1) * 128 * 64; const bf16_t* vg = vg0 + (size_t)(jj + 1) * 128;
            kreg[0] = *(const u32x4*)kg; kreg[1] = *(const u32x4*)(kg + 64 * 64); vreg[0] = *(const u32x4*)vg; vreg[1] = *(const u32x4*)(vg + (size_t)32 * S); }
        const LAS unsigned char* Kb = L + (cur ? AT_KB1 : AT_KB0);
        const LAS unsigned char* Vb = L + (cur ? AT_VB1 : AT_VB0);
        if (jj + 2 < ns) att_step<TYPE, false>(Kb, Vb, CUM, jj, qb, wave, tq, r32, hi, cq, qr, mk0, mk1, lrun, o);
        else att_step<TYPE, true>(Kb, Vb, CUM, jj, qb, wave, tq, r32, hi, cq, qr, mk0, mk1, lrun, o);
        if (jj + 1 < ns) { LAS unsigned char* Kn = L + (cur ? AT_KB0 : AT_KB1); LAS unsigned char* Vn = L + (cur ? AT_VB0 : AT_VB1);
            *(LAS u32x4*)(Kn + ksoff) = kreg[0]; *(LAS u32x4*)(Kn + ksoff + 64 * AT_KP) = kreg[1]; *(LAS u32x4*)(Vn + vsoff) = vreg[0]; *(LAS u32x4*)(Vn + vsoff + 32 * AT_VP) = vreg[1]; }
        __syncthreads();
    }
    bf16_t* orow = c.AB() + (size_t)(b * S + tq) * D + ocol;
    if (TYPE != 1) {
        const float lt = lrun[0] + __shfl_xor(lrun[0], 32), inv = 1.0f / lt;
#pragma unroll
        for (int db = 0; db < 2; ++db)
#pragma unroll
            for (int g = 0; g < 4; ++g) { u32x2 w; w.x = pk2(o[0][db][4 * g] * inv, o[0][db][4 * g + 1] * inv); w.y = pk2(o[0][db][4 * g + 2] * inv, o[0][db][4 * g + 3] * inv);
                *(u32x2*)(orow + 32 * db + 8 * g + 4 * hi) = w; }
    } else {
        float s1 = 0.f, s2 = 0.f;
        for (int i = 0; i < 32; ++i) { s1 += c.in(8)[l * 32 + i] * c.in(9)[l * 32 + i]; s2 += c.in(10)[l * 32 + i] * c.in(11)[l * 32 + i]; }
        const float lam_init = 0.8f - 0.6f * expf(-0.3f * (float)l);
        const float lam = expf(s1) - expf(s2) + lam_init;
        const float inv0 = 1.0f / (lrun[0] + __shfl_xor(lrun[0], 32)), inv1 = lam / (lrun[NMAP - 1] + __shfl_xor(lrun[NMAP - 1], 32));
        float ss = 0.f;
#pragma unroll
        for (int db = 0; db < 2; ++db)
#pragma unroll
            for (int r = 0; r < 16; ++r) { const float v = o[0][db][r] * inv0 - o[NMAP - 1][db][r] * inv1; o[0][db][r] = v; ss += v * v; }
        ss += __shfl_xor(ss, 32);
        const float rn = (1.0f - lam_init) / sqrtf(ss * (1.f / 64.f) + EPS);
        const float* gs = c.in(12) + l * 64;
#pragma unroll
        for (int db = 0; db < 2; ++db)
#pragma unroll
            for (int g = 0; g < 4; ++g) { const f32x4 gv = *(const f32x4*)(gs + 32 * db + 8 * g + 4 * hi);
                u32x2 w; w.x = pk2(o[0][db][4 * g] * rn * gv[0], o[0][db][4 * g + 1] * rn * gv[1]); w.y = pk2(o[0][db][4 * g + 2] * rn * gv[2], o[0][db][4 * g + 3] * rn * gv[3]);
                *(u32x2*)(orow + 32 * db + 8 * g + 4 * hi) = w; }
    }
}

constexpr int A6_KB0 = 0, A6_KB1 = 9216, A6_VB0 = 18432, A6_VB1 = 27648, A6_CUM = 36864, A6_SCR = 45056;
template <int TYPE>
__device__ __forceinline__ void attn_unit64(const Ctx& c, int l, int b, int h, int qb, LAS unsigned char* L) {
    constexpr int NMAP = TYPE == 1 ? 2 : 1, KS = 4 / NMAP;
    const int tid = otid(c.wv), lane = tid & 63, wave = __builtin_amdgcn_readfirstlane(tid >> 6), r32 = lane & 31, hi = lane >> 5;
    const bf16_t *Qp, *Kp, *Vp; int ocol;
    if (TYPE == 0) { Qp = c.FQ() + (size_t)(b * 6 + h) * S * 64; Kp = c.FK() + (size_t)(b * 6 + h) * S * 64; Vp = c.VT() + (size_t)(b * 11 + h) * 64 * S; ocol = 64 * h; }
    else if (TYPE == 1) { Qp = c.DQ() + (size_t)(b * 4 + h) * S * 64; Kp = c.DK() + (size_t)(b * 4 + h) * S * 64; Vp = c.VT() + (size_t)(b * 11 + 6 + h) * 64 * S; ocol = 384 + 64 * h; }
    else { Qp = c.SQ() + (size_t)(b * 6 + h) * S * 64; Kp = c.SK() + (size_t)b * S * 64; Vp = c.VT() + (size_t)(b * 11 + 10) * 64 * S; ocol = 640 + 64 * h; }
    const int q0 = 256 * qb, tq = q0 + 32 * wave + r32, nt = 4 * (qb + 1);
    const int srow = tid >> 3, sch = tid & 7;
    const bf16_t* kg = Kp + (size_t)srow * 64 + sch * 8;
    const bf16_t* vg = Vp + (size_t)srow * S + sch * 8;
    const unsigned soff = srow * 144 + sch * 16;
    u32x4 kreg[2], vreg[2];
    kreg[0] = *(const u32x4*)kg; vreg[0] = *(const u32x4*)vg; kreg[1] = *(const u32x4*)(kg + 4096); vreg[1] = *(const u32x4*)(vg + 64);
    bf16x8 qr[4];
#pragma unroll
    for (int d0 = 0; d0 < 4; ++d0) qr[d0] = *(const bf16x8*)(Qp + (size_t)tq * 64 + d0 * 16 + hi * 8);
    u32x4 mk0[4], mk1[4];
#pragma unroll
    for (int g = 0; g < 4; ++g) { mk0[g] = (u32x4){0u, 0u, 0u, 0u}; mk1[g] = (u32x4){0u, 0u, 0u, 0u}; }
    if (TYPE == 2) { const unsigned* mrow = c.MASK() + (size_t)(b * S + tq) * 64 + 4 * hi;
#pragma unroll
        for (int g = 0; g < 4; ++g) { mk0[g] = *(const u32x4*)(mrow + 8 * g); mk1[g] = *(const u32x4*)(mrow + 32 + 8 * g); } }
    LAS float* CUM = (LAS float*)(L + A6_CUM);
    if (TYPE == 0) {
        LAS float* SCR = (LAS float*)(L + A6_SCR);
        const f32x4 lf = *(const f32x4*)(c.LOGF() + (size_t)(b * 6 + h) * S + 4 * tid);
        const float a0 = lf[0], a1 = a0 + lf[1], a2 = a1 + lf[2], a3 = a2 + lf[3];
        float incl = a3;
#pragma unroll 1
        for (int off = 1; off < 64; off <<= 1) { const float n = __shfl_up(incl, off); if (lane >= off) incl += n; }
        if (lane == 63) SCR[wave] = incl;
        __syncthreads();
        float base = 0.f;
#pragma unroll
        for (int w = 0; w < NWAVES; ++w) if (w < wave) base += SCR[w];
        const float ex = incl - a3 + base;
        f32x4 cv; cv[0] = (ex + a0) * LOG2E; cv[1] = (ex + a1) * LOG2E; cv[2] = (ex + a2) * LOG2E; cv[3] = (ex + a3) * LOG2E;
        *(LAS f32x4*)(CUM + 4 * tid) = cv;
    }
    *(LAS u32x4*)(L + A6_KB0 + soff) = kreg[0]; *(LAS u32x4*)(L + A6_VB0 + soff) = vreg[0];
    __syncthreads();
    float cq = 0.f; if (TYPE == 0) cq = CUM[tq];
    float lrun[NMAP]; f32x16 o[NMAP][2];
#pragma unroll
    for (int mp = 0; mp < NMAP; ++mp) { lrun[mp] = 0.f;
#pragma unroll
        for (int r = 0; r < 16; ++r) { o[mp][0][r] = 0.f; o[mp][1][r] = 0.f; } }
#pragma unroll 1
    for (int j2 = 0; j2 < nt; j2 += 2) {
#pragma unroll
      for (int jp = 0; jp < 2; ++jp) {
        const int j = j2 + jp, cur = jp;
        if (j + 2 < nt) { kreg[jp] = *(const u32x4*)(kg + (size_t)(j + 2) * 4096); vreg[jp] = *(const u32x4*)(vg + (size_t)(j + 2) * 64); }
        const int jb = j - 4 * qb;
        const bool skip = (jb >= 0) && (64 * jb > 32 * wave + 31);
        if (!skip) {
            const LAS unsigned char* Kb = L + (cur ? A6_KB1 : A6_KB0);
            const LAS unsigned char* Vb = L + (cur ? A6_VB1 : A6_VB0);
#pragma unroll
            for (int mp = 0; mp < NMAP; ++mp) {
                f32x16 p0, p1;
                if (TYPE == 0) {
#pragma unroll
                    for (int g = 0; g < 4; ++g) { const f32x4 c0 = *(const LAS f32x4*)(CUM + 64 * j + 8 * g + 4 * hi), c1 = *(const LAS f32x4*)(CUM + 64 * j + 32 + 8 * g + 4 * hi);
#pragma unroll
                        for (int i = 0; i < 4; ++i) { p0[4 * g + i] = cq - c0[i]; p1[4 * g + i] = cq - c1[i]; } }
                } else {
#pragma unroll
                    for (int r = 0; r < 16; ++r) { p0[r] = 0.f; p1[r] = 0.f; }
                }
#pragma unroll
                for (int ks = 0; ks < KS; ++ks) { const int d0 = mp * KS + ks;
                    const bf16x8 a0 = *(const LAS bf16x8*)(Kb + r32 * 144 + d0 * 32 + hi * 16);
                    const bf16x8 a1 = *(const LAS bf16x8*)(Kb + (32 + r32) * 144 + d0 * 32 + hi * 16);
                    p0 = __builtin_amdgcn_mfma_f32_32x32x16_bf16(a0, qr[d0], p0, 0, 0, 0);
                    p1 = __builtin_amdgcn_mfma_f32_32x32x16_bf16(a1, qr[d0], p1, 0, 0, 0); }
                if (TYPE != 2) {
                    if (jb >= 0) { const int base = tq - 64 * j - 4 * hi;
#pragma unroll
                        for (int r = 0; r < 16; ++r) { const int kk = (r & 3) + 8 * (r >> 2); if (kk > base) p0[r] = NEGBIG; if (kk + 32 > base) p1[r] = NEGBIG; } }
                }
                float ls = 0.f;
                if (TYPE == 2) {
#pragma unroll
                    for (int r = 0; r < 16; ++r) {
                        const int m0 = __builtin_amdgcn_sbfe((int)mk0[r >> 2][r & 3], (unsigned)j, 1u), m1 = __builtin_amdgcn_sbfe((int)mk1[r >> 2][r & 3], (unsigned)j, 1u);
                        p0[r] = __builtin_bit_cast(float, __builtin_bit_cast(int, __builtin_amdgcn_exp2f(p0[r])) & m0);
                        p1[r] = __builtin_bit_cast(float, __builtin_bit_cast(int, __builtin_amdgcn_exp2f(p1[r])) & m1); ls += p0[r] + p1[r]; }
                } else {
#pragma unroll
                for (int r = 0; r < 16; ++r) { p0[r] = __builtin_amdgcn_exp2f(p0[r]); p1[r] = __builtin_amdgcn_exp2f(p1[r]); ls += p0[r] + p1[r]; }
                }
                lrun[mp] += ls;
                u32x4 pw[2][2];
#pragma unroll
                for (int cc = 0; cc < 2; ++cc) {
                    pw[0][cc].x = pk2(p0[8 * cc + 0], p0[8 * cc + 1]); pw[0][cc].y = pk2(p0[8 * cc + 2], p0[8 * cc + 3]); pw[0][cc].z = pk2(p0[8 * cc + 4], p0[8 * cc + 5]); pw[0][cc].w = pk2(p0[8 * cc + 6], p0[8 * cc + 7]);
                    pw[1][cc].x = pk2(p1[8 * cc + 0], p1[8 * cc + 1]); pw[1][cc].y = pk2(p1[8 * cc + 2], p1[8 * cc + 3]); pw[1][cc].z = pk2(p1[8 * cc + 4], p1[8 * cc + 5]); pw[1][cc].w = pk2(p1[8 * cc + 6], p1[8 * cc + 7]); }
#pragma unroll
                for (int pp = 0; pp < 2; ++pp)
#pragma unroll
                    for (int cc = 0; cc < 2; ++cc)
#pragma unroll
                        for (int db = 0; db < 2; ++db) {
                            const bf16x8 av = *(const LAS bf16x8*)(Vb + (32 * db + r32) * 144 + pp * 64 + hi * 32 + cc * 16);
                            o[mp][db] = __builtin_amdgcn_mfma_f32_32x32x16_bf16(av, __builtin_bit_cast(bf16x8, pw[pp][cc]), o[mp][db], 0, 0, 0); }
            }
        }
        if (j + 1 < nt) { *(LAS u32x4*)(L + (cur ? A6_KB0 : A6_KB1) + soff) = kreg[jp ^ 1]; *(LAS u32x4*)(L + (cur ? A6_VB0 : A6_VB1) + soff) = vreg[jp ^ 1]; }
        __syncthreads();
      }
    }
    bf16_t* orow = c.AB() + (size_t)(b * S + tq) * D + ocol;
    if (TYPE != 1) {
        const float lt = lrun[0] + __shfl_xor(lrun[0], 32), inv = 1.0f / lt;
#pragma unroll
        for (int db = 0; db < 2; ++db)
#pragma unroll
            for (int g = 0; g < 4; ++g) { u32x2 w; w.x = pk2(o[0][db][4 * g] * inv, o[0][db][4 * g + 1] * inv); w.y = pk2(o[0][db][4 * g + 2] * inv, o[0][db][4 * g + 3] * inv);
                *(u32x2*)(orow + 32 * db + 8 * g + 4 * hi) = w; }
    } else {
        float s1 = 0.f, s2 = 0.f;
        for (int i = 0; i < 32; ++i) { s1 += c.in(8)[l * 32 + i] * c.in(9)[l * 32 + i]; s2 += c.in(10)[l * 32 + i] * c.in(11)[l * 32 + i]; }
        const float lam_init = 0.8f - 0.6f * expf(-0.3f * (float)l);
        const float lam = expf(s1) - expf(s2) + lam_init;
        const float inv0 = 1.0f / (lrun[0] + __shfl_xor(lrun[0], 32)), inv1 = lam / (lrun[NMAP - 1] + __shfl_xor(lrun[NMAP - 1], 32));
        float ss = 0.f;
#pragma unroll
        for (int db = 0; db < 2; ++db)
#pragma unroll
            for (int r = 0; r < 16; ++r) { const float v = o[0][db][r] * inv0 - o[NMAP - 1][db][r] * inv1; o[0][db][r] = v; ss += v * v; }
        ss += __shfl_xor(ss, 32);
        const float rn = (1.0f - lam_init) / sqrtf(ss * (1.f / 64.f) + EPS);
        const float* gs = c.in(12) + l * 64;
#pragma unroll
        for (int db = 0; db < 2; ++db)
#pragma unroll
            for (int g = 0; g < 4; ++g) { const f32x4 gv = *(const f32x4*)(gs + 32 * db + 8 * g + 4 * hi);
                u32x2 w; w.x = pk2(o[0][db][4 * g] * rn * gv[0], o[0][db][4 * g + 1] * rn * gv[1]); w.y = pk2(o[0][db][4 * g + 2] * rn * gv[2], o[0][db][4 * g + 3] * rn * gv[3]);
                *(u32x2*)(orow + 32 * db + 8 * g + 4 * hi) = w; }
    }
}

#define XB_TMO      128
#define XB_XCNT(j)  (256  + 64 * (j))
#define XB_XSUB(j)  (1280 + 64 * (j))
#define XB_XGEN(j)  (2304 + 64 * (j))
#define XB_TOP      3328
#define XB_TOPGEN   3392
#define XCD_BAR_WORDS 3456
#define XB_SPIN_CAP (1u << 18)

__device__ __forceinline__ unsigned xb_ld(unsigned* p)              { return __hip_atomic_load(p, __ATOMIC_RELAXED, __HIP_MEMORY_SCOPE_AGENT); }
__device__ __forceinline__ unsigned xb_add(unsigned* p, unsigned v) { return __hip_atomic_fetch_add(p, v, __ATOMIC_RELAXED, __HIP_MEMORY_SCOPE_AGENT); }
__device__ __forceinline__ unsigned xb_xcc_id() { return (unsigned)__builtin_amdgcn_s_getreg((3 << 11) | 20) & 0xFu; }
#define XB_SPIN(cond, bar) do { unsigned _sp = 0; while (cond) { __builtin_amdgcn_s_sleep(1); \
    if ((++_sp & 255u) == 0u) { if (xb_ld(&(bar)[XB_TMO])) break; if (_sp > XB_SPIN_CAP) { atomicAdd(&(bar)[XB_TMO], 1u); break; } } } } while (0)

struct XcdBarrier {
    unsigned* bar; unsigned x; int wv;
    volatile LAS unsigned* st;
};

__device__ __forceinline__ XcdBarrier xcd_barrier_post(unsigned* bar, volatile LAS unsigned* st, int wv) {
    XcdBarrier b; b.bar = bar; b.x = xb_xcc_id(); b.st = st; b.wv = wv;
    if (wv == 0 && lane_id() == 0) (void)xb_add(&bar[XB_XCNT(b.x)], 1u);
    return b;
}
__device__ __forceinline__ void xcd_barrier_complete(unsigned* bar, unsigned x, unsigned& nloc, unsigned& nx) {
    const unsigned G = gridDim.x * gridDim.y * gridDim.z;
    unsigned sum, cnt, mine, sp = 0u;
    for (;;) {
        sum = 0u; cnt = 0u; mine = 0u;
#pragma unroll
        for (unsigned j = 0; j < 16; ++j) { const unsigned c = xb_ld(&bar[XB_XCNT(j)]); sum += c; cnt += (c > 0u) ? 1u : 0u; mine = (j == x) ? c : mine; }
        if (sum == G) break;
        __builtin_amdgcn_s_sleep(1);
        if ((++sp & 255u) == 0u) { if (xb_ld(&bar[XB_TMO])) break; if (sp > XB_SPIN_CAP) { atomicAdd(&bar[XB_TMO], 1u); break; } }
    }
    nloc = mine > 0u ? mine : 1u; nx = cnt > 0u ? cnt : 1u;
}

__device__ __forceinline__ void xcd_barrier(const XcdBarrier& b) {
    asm volatile("s_waitcnt vmcnt(0)" ::: "memory");
    __syncthreads();
    if (b.wv == 0 && lane_id() == 0) {
        unsigned* bar = b.bar;
        __builtin_amdgcn_s_waitcnt(0);
        unsigned nloc = b.st[0], nx = b.st[1];
        if (nloc == 0u) { xcd_barrier_complete(bar, b.x, nloc, nx); b.st[0] = nloc; b.st[1] = nx; }
        const unsigned old = xb_add(&bar[XB_XSUB(b.x)], 1u);
        const unsigned gen = old / nloc;
        if (old + 1u == (gen + 1u) * nloc) {
            __builtin_amdgcn_fence(__ATOMIC_RELEASE, "agent");
            asm volatile("s_waitcnt vmcnt(0)" ::: "memory");
            const unsigned og = xb_add(&bar[XB_TOP], 1u);
            const unsigned tg = og / nx;
            asm volatile("buffer_inv sc1" ::: "memory");
            if (og + 1u == (tg + 1u) * nx) xb_add(&bar[XB_TOPGEN], 1u);
            else XB_SPIN(xb_ld(&bar[XB_TOPGEN]) == tg, bar);
            asm volatile("" ::: "memory");
            xb_add(&bar[XB_XGEN(b.x)], 1u);
            asm volatile("s_waitcnt vmcnt(0)" ::: "memory");
        } else {
            asm volatile("buffer_inv sc1" ::: "memory");
            XB_SPIN(xb_ld(&bar[XB_XGEN(b.x)]) == gen, bar);
            asm volatile("" ::: "memory");
            asm volatile("s_waitcnt vmcnt(0)" ::: "memory");
        }
    }
    __syncthreads();
}

__global__ void __launch_bounds__(NTHR, 2) trunk_fwd(Args a) {
    extern __shared__ __attribute__((aligned(16))) unsigned char lds[];
    cg::grid_group grid = cg::this_grid();
    LAS unsigned char* L = (LAS unsigned char*)lds;
    const int wv = __builtin_amdgcn_readfirstlane((int)threadIdx.x >> 6);
    const Ctx c{a, wv};
    volatile LAS unsigned* xst = (volatile LAS unsigned*)(L + 147200);
    if (wv == 0 && lane_id() == 0) { xst[0] = 0u; xst[1] = 0u; }
    __syncthreads();
    unsigned* barw = (unsigned*)(a.ws + WS_BAR);
    XcdBarrier xbar; xbar.bar = barw; xbar.x = 0; xbar.st = xst; xbar.wv = wv;
    const int lo = a.ph_lo, hi = a.ph_hi, G = gridDim.x, cid = blockIdx.x;
#ifndef PHMASK
#define PHMASK 0xFF
#endif
#define PK_(k) (((PHMASK) >> (k)) & 1)
#ifndef DUPMASK
#define DUPMASK 0
#endif
#define REP_(k) for (int rep_ = 0; rep_ < 1 + (((DUPMASK) >> (k)) & 1); ++rep_)
#define RUN(p) ((p) >= lo && (p) < hi)
#define SEAM(p) do { if (RUN(p) && RUN((p) + 1)) { REP_(8) xcd_barrier(xbar); } } while (0)
    xbar = xcd_barrier_post(barw, xst, wv);
    if (lo < 0) grid.sync();
    if (PK_(0) && RUN(0)) REP_(0) phase0(c, a, L);
    xcd_barrier(xbar);
#pragma unroll 1
    for (int l = 0; l < DEPTH; ++l) {
        const int pb = 1 + 7 * l;
        const float* xin = l == 0 ? c.in(0) : c.out();
        if (PK_(2) && RUN(pb + 0)) REP_(2) { pg8::Gemm g{c.XB(), c.Win() + (size_t)l * INP * D, M, INP, D}; pg8::StaticOrder So; So.init(M, INP, G, cid);
            EpiProj E{c.PROJ(), c.SIDE(), c.SSQ()}; pg8::gemm_phase<EpiProj, pg8::StaticOrder, true, true>(L, g, So, E, wv); }
        SEAM(pb + 0);
        if (PK_(3) && RUN(pb + 1)) REP_(3) prep_phase(c, l, L);
        SEAM(pb + 1);
        if (PK_(4) && RUN(pb + 2)) REP_(4) {
            const int rounds = (NB * 128 + G - 1) / G;
            for (int i = 0; i < rounds; ++i) { const int Lx = i * G + ((i & 1) ? G - 1 - cid : cid); if (Lx < NB * 128) idx_unit(c, Lx % NB, 127 - Lx / NB, L); }
        }
        SEAM(pb + 2);
        if (PK_(5) && RUN(pb + 3)) REP_(5) {
            if (G == 256) {
                const int qd = cid >> 5, i32 = cid & 31;
                const unsigned tab = qd == 7 ? (0u | 4u << 5 | 20u << 10) : qd == 6 ? (1u | 8u << 5 | 21u << 10) : qd == 5 ? (2u | 12u << 5 | 24u << 10) : qd == 4 ? (5u | 9u << 5 | 28u << 10)
                                   : qd == 3 ? (6u | 13u << 5 | 29u << 10) : qd == 2 ? (10u | 16u << 5 | 25u << 10) : qd == 1 ? (14u | 17u << 5 | 30u << 10) : (18u | 22u << 5 | 26u << 10);
#ifndef ATT_ONLY
#define ATT_ONLY 7
#endif
                if (ATT_ONLY & 2) attn_unit64<1>(c, l, i32 / 4, i32 % 4, qd, L);
#pragma unroll 1
                for (int k = 2; k >= 0; --k) { const unsigned e = (tab >> (5 * k)) & 31u; const int qb = (int)(e >> 2), u = 32 * (int)(e & 3u) + i32;
                    if (u < 48) { if (ATT_ONLY & 1) attn_unit<0>(c, l, u / 6, u % 6, qb, L); } else { if (ATT_ONLY & 4) attn_unit64<2>(c, l, (u - 48) / 6, (u - 48) % 6, qb, L); } }
            } else {
                const int rounds = (1024 + G - 1) / G;
                for (int i = 0; i < rounds; ++i) { const int Lx = i * G + ((i & 1) ? G - 1 - cid : cid);
                    if (Lx < 1024) { const int qb = 7 - Lx / 128, w = Lx % 128;
                        if (w < 32) { if (ATT_ONLY & 2) attn_unit64<1>(c, l, w / 4, w % 4, qb, L); }
                        else if (w < 80) { if (ATT_ONLY & 1) attn_unit<0>(c, l, (w - 32) / 6, (w - 32) % 6, qb, L); }
                        else { if (ATT_ONLY & 4) attn_unit64<2>(c, l, (w - 80) / 6, (w - 80) % 6, qb, L); } } }
            }
        }
        SEAM(pb + 3);
        if (PK_(6) && RUN(pb + 4)) { pg8::Gemm g{c.AB(), c.Wout() + (size_t)l * D * D, M, D, D}; pg8::StaticOrder So; So.init(M, D, G, cid);
            EpiResid E{xin, c.out(), c.XB(), c.SSQ() + (size_t)16 * M}; pg8::gemm_phase<EpiResid, pg8::StaticOrder, true, true>(L, g, So, E, wv); }
        SEAM(pb + 4);
        if (PK_(7) && RUN(pb + 5)) REP_(7) { pg8::Gemm g{c.XB(), c.Wgu() + (size_t)l * GU * D, M, GU, D}; pg8::StaticOrder So; So.init(M, GU, G, cid);
            EpiSwiglu E{c.PROJ(), c.SSQ() + (size_t)16 * M}; pg8::gemm_phase<EpiSwiglu, pg8::StaticOrder, true, true>(L, g, So, E, wv);
            if (l + 1 < DEPTH && G == 256 && cid >= 128) { const int tid2 = otid(wv); convert_layer(c, l + 1, (cid - 128) * NWAVES + (tid2 >> 6), 128 * NWAVES, (LAS float*)(L + (tid2 >> 6) * 16640), tid2 & 63); } }
        SEAM(pb + 5);
        if (PK_(6) && RUN(pb + 6)) { pg8::Gemm g{c.PROJ(), c.Wdn() + (size_t)l * D * FF, M, D, FF}; pg8::StaticOrder So; So.init(M, D, G, cid);
            EpiResid E{c.out(), c.out(), l + 1 < DEPTH ? c.XB() : nullptr, c.SSQ()}; pg8::gemm_phase<EpiResid, pg8::StaticOrder, true, true>(L, g, So, E, wv); }
        SEAM(pb + 6);
    }
#undef RUN
#undef SEAM
}

extern "C" void kernel_launch(void* const* d_in, const int* in_sizes, int n_in, void* d_out, int out_size, void* d_ws, size_t ws_size, hipStream_t stream) {
    static int grid = 0;
    if (grid == 0) {
        if (n_in != 19 || in_sizes[0] != M * D || out_size != M * D || ws_size < WS_END) { fprintf(stderr, "kernel_launch: shape/workspace mismatch (n_in %d, in0 %d, out %d, ws %zu < %zu)\n", n_in, n_in > 0 ? in_sizes[0] : -1, out_size, ws_size, (size_t)WS_END); grid = -1; return; }
        int dev = 0, cus = 0, per_cu = 0;
        (void)hipGetDevice(&dev); (void)hipDeviceGetAttribute(&cus, hipDeviceAttributeMultiprocessorCount, dev);
        if (hipFuncSetAttribute((const void*)trunk_fwd, hipFuncAttributeMaxDynamicSharedMemorySize, LDS_BYTES) != hipSuccess) { fprintf(stderr, "kernel_launch: hipFuncSetAttribute failed\n"); grid = -1; return; }
        if (hipOccupancyMaxActiveBlocksPerMultiprocessor(&per_cu, (const void*)trunk_fwd, NTHR, LDS_BYTES) != hipSuccess || per_cu < 1) { fprintf(stderr, "kernel_launch: occupancy query says %d\n", per_cu); per_cu = 1; }
        (void)hipGetLastError();
        grid = cus * 1;
        (void)per_cu;
    }
    if (grid < 0) return;
    if (hipMemsetAsync((char*)d_ws + WS_BAR, 0, XCD_BAR_WORDS * 4, stream) != hipSuccess) { fprintf(stderr, "kernel_launch: hipMemsetAsync of the barrier words failed\n"); return; }
    Args a{};
    for (int i = 0; i < 19; ++i) a.in[i] = (const float*)d_in[i];
    a.out = (float*)d_out; a.ws = (unsigned char*)d_ws;
    for (int i = 0; i < 8; ++i) a.invf[i] = 1.0f / (float)pow(500000.0, (double)i / 8.0);
    for (int i = 0; i < 4; ++i) a.invf[8 + i] = 1.0f / (float)pow(500000.0, (double)i / 4.0);
    a.ph_lo = 0; a.ph_hi = NPH;
    void* args[] = {&a};
    hipError_t e = hipLaunchCooperativeKernel((const void*)trunk_fwd, dim3(grid), dim3(NTHR), args, LDS_BYTES, stream);
    if (e != hipSuccess) fprintf(stderr, "cooperative launch failed: %s (grid %d)\n", hipGetErrorString(e), grid);
}
```

```cpp
#include <hip/hip_runtime.h>
#include <hip/hip_cooperative_groups.h>
#include <cstdio>
#include <cstdint>
#include <cmath>
namespace cg = cooperative_groups;
#define DUPMASK 0
namespace pg8 {
#define PG8_LAS __attribute__((address_space(3)))
typedef unsigned short bf16_t;
typedef short bf16x8 __attribute__((ext_vector_type(8)));
typedef float f32x4 __attribute__((ext_vector_type(4)));
typedef unsigned u32x4 __attribute__((ext_vector_type(4)));
constexpr int BM = 256, BK = 64, HALF = 128, HTB = HALF * BK * 2  , STAGE_BYTES = 8 * HTB, NXCD = 8, WGM = 8;

__host__ __device__ __forceinline__ int lds_byte(int r, int c) { const int st = (r >> 4) * 2 + (c >> 5), rr = r & 15, cc = c & 31, ob = rr * 64 + cc * 2; return st * 1024 + (ob ^ (((ob >> 9) & 1) << 5)); }
__host__ __device__ __forceinline__ void stage_rc(int b, int& R, int& C) { const int st = b / 1024, sb = b % 1024, swz = sb ^ (((sb >> 9) & 1) << 5); R = (st >> 1) * 16 + swz / 64; C = (st & 1) * 32 + (swz % 64) / 2; }
__host__ __device__ __forceinline__ int perm32(int rho) { const int n = rho >> 4, i = rho & 15; return 8 * (i >> 2) + 4 * n + (i & 3); }

struct Unit { int pm, pn; };
struct Gemm { const bf16_t* A; const bf16_t* Bt; int M, N, K; };

struct StaticOrder {
    int nM, nN, nwg, G, c;
    __host__ __device__ void init(int M, int N, int G_, int c_) { nM = M / BM; nN = N / BM; nwg = nM * nN; G = G_; c = c_; }
    __host__ __device__ bool next(int i, Unit& u) const {
        const long L = (long)i * G + c; if (L >= nwg) return false;
        int wgid = (int)L; { const int q = nwg / NXCD, r = nwg % NXCD, xcd = wgid % NXCD, off = wgid / NXCD; wgid = (xcd < r ? xcd * (q + 1) : r * (q + 1) + (xcd - r) * q) + off; }
        const int nig = WGM * nN, gid = wgid / nig, fm = gid * WGM, gsz = (nM - fm) < WGM ? (nM - fm) : WGM;
        u.pm = fm + ((wgid % nig) % gsz); u.pn = (wgid % nig) / gsz; return true;
    }
    __device__ __forceinline__ void a_ready(const Unit&) const {}
    __device__ __forceinline__ void done(const Unit&) const {}
};
__device__ __forceinline__ unsigned cvt_pk_bf16(float lo, float hi) { unsigned r; asm volatile("v_cvt_pk_bf16_f32 %0, %1, %2" : "=v"(r) : "v"(lo), "v"(hi)); return r; }
template <class Epi, class Sched, bool ALIGN_EPI = false, bool SP2 = false>
__device__ __forceinline__ void gemm_phase(PG8_LAS unsigned char* lds, const Gemm g, const Sched& S, const Epi& E, const int wv_in) {
    unsigned mm_ = ~0u; asm volatile("" : "+s"(mm_)); int tid_ = wv_in * 64 + (int)__builtin_amdgcn_mbcnt_hi(mm_, __builtin_amdgcn_mbcnt_lo(mm_, 0u)); asm volatile("" : "+v"(tid_)); const int tid = tid_, wid = __builtin_amdgcn_readfirstlane(tid >> 6), lane = tid & 63, wr = wid >> 2, wc = wid & 3, fr = lane & 15, fq = lane >> 4;
    const int K = g.K, nt = K / BK;
    unsigned voffA[2], voffB[2];
#pragma unroll
    for (int i = 0; i < 2; ++i) { int R, C; stage_rc(tid * 16 + i * 8192, R, C); const int Rb = Epi::PERM ? ((R & ~31) + perm32(R & 31)) : R;
        voffA[i] = (unsigned)(R * K + C) * 2u; voffB[i] = (unsigned)(Rb * K + C) * 2u; }
    const size_t kstep = (size_t)(BK * 2);
    const size_t hstep = (size_t)HALF * K * 2;
    const size_t tstep = 2 * hstep;
    const unsigned ldsw = (unsigned)wid * 1024u;
    const int aoff = lds_byte(wr * 64 + fr, fq * 8), boff = lds_byte(wc * 32 + fr, fq * 8);
#define PG8_SA(b, h) (((b) * 2 + (h)) * HTB)
#define PG8_SB(b, h) ((4 + (b) * 2 + (h)) * HTB)
#define PG8_STAGE(bufoff, gbase, voff) do { _Pragma("unroll") for (int _i = 0; _i < 2; ++_i) \
        __builtin_amdgcn_global_load_lds((const unsigned*)((const char*)(gbase) + (voff)[_i]), (PG8_LAS unsigned*)(lds + (bufoff) + ldsw + _i * 8192), 16, 0, 0); } while (0)
#define PG8_LDA(dst, b, h) do { _Pragma("unroll") for (int m = 0; m < 4; ++m) _Pragma("unroll") for (int k = 0; k < 2; ++k) dst[m][k] = *(const PG8_LAS bf16x8*)(lds + PG8_SA(b, h) + aoff + m * 2048 + k * 1024); } while (0)
#define PG8_LDB(dst, b, h) do { _Pragma("unroll") for (int n = 0; n < 2; ++n) _Pragma("unroll") for (int k = 0; k < 2; ++k) dst[n][k] = *(const PG8_LAS bf16x8*)(lds + PG8_SB(b, h) + boff + n * 2048 + k * 1024); } while (0)
#define PG8_MMA(ai, bj, At, Bt) do { __builtin_amdgcn_s_setprio(1); _Pragma("unroll") for (int m = 0; m < 4; ++m) _Pragma("unroll") for (int n = 0; n < 2; ++n) _Pragma("unroll") for (int k = 0; k < 2; ++k) \
        acc[ai][bj][m][n] = __builtin_amdgcn_mfma_f32_16x16x32_bf16(Bt[n][k], At[m][k], acc[ai][bj][m][n], 0, 0, 0); __builtin_amdgcn_s_setprio(0); } while (0)
#define PG8_WAIT_V(n) asm volatile("s_waitcnt vmcnt(" #n ")" ::: "memory")
#define PG8_WAIT_L(n) asm volatile("s_waitcnt lgkmcnt(" #n ")" ::: "memory")
#define PG8_BAR __builtin_amdgcn_s_barrier()
#define PG8_SCHED __builtin_amdgcn_sched_barrier(0)
    Unit cur, nxt; int ui = 0;
    if (!S.next(0, cur)) return;
    f32x4 acc[2][2][4][2];
#pragma unroll
    for (int a = 0; a < 2; ++a)
#pragma unroll
        for (int b = 0; b < 2; ++b)
#pragma unroll
            for (int m = 0; m < 4; ++m)
#pragma unroll
                for (int n = 0; n < 2; ++n) acc[a][b][m][n] = (f32x4){0.f, 0.f, 0.f, 0.f};
    bf16x8 At[4][2], B0[2][2], B1[2][2];
    const char* cA = (const char*)g.A + (size_t)cur.pm * tstep; const char* cB = (const char*)g.Bt + (size_t)cur.pn * tstep;
    S.a_ready(cur);
    if constexpr (SP2) {
        PG8_STAGE(PG8_SB(0, 0), cB, voffB); PG8_STAGE(PG8_SB(0, 1), cB + hstep, voffB); PG8_STAGE(PG8_SA(0, 0), cA, voffA); PG8_STAGE(PG8_SA(0, 1), cA + hstep, voffA);
        if (wr == 1) PG8_BAR;
        PG8_WAIT_V(2); PG8_BAR;
        PG8_STAGE(PG8_SB(1, 0), cB + kstep, voffB); PG8_STAGE(PG8_SA(1, 0), cA + kstep, voffA); PG8_STAGE(PG8_SB(1, 1), cB + hstep + kstep, voffB);
        PG8_WAIT_V(6); PG8_BAR;
    } else {
        PG8_STAGE(PG8_SB(0, 0), cB, voffB); PG8_STAGE(PG8_SA(0, 0), cA, voffA); PG8_STAGE(PG8_SB(0, 1), cB + hstep, voffB); PG8_STAGE(PG8_SA(0, 1), cA + hstep, voffA);
        if (wr == 1) PG8_BAR;
        PG8_WAIT_V(4); PG8_BAR;
        PG8_STAGE(PG8_SB(1, 0), cB + kstep, voffB); PG8_STAGE(PG8_SA(1, 0), cA + kstep, voffA); PG8_STAGE(PG8_SB(1, 1), cB + hstep + kstep, voffB);
        PG8_WAIT_V(6); PG8_BAR;
    }
    for (;;) {
        const bool has_next = S.next(ui + 1, nxt);
        const char* nA = has_next ? (const char*)g.A + (size_t)nxt.pm * tstep : cA; const char* nB = has_next ? (const char*)g.Bt + (size_t)nxt.pn * tstep : cB;
        for (int t = 0; t < nt; t += 2) {
            const bool last = (t == nt - 2);
            const char* a1 = cA + (size_t)(t + 1) * kstep;
            const char* a2 = last ? nA : cA + (size_t)(t + 2) * kstep; const char* b2 = last ? nB : cB + (size_t)(t + 2) * kstep;
            const char* a3 = a2 + kstep; const char* b3 = b2 + kstep;
            if (last && has_next) S.a_ready(nxt);
            if constexpr (SP2) {
            PG8_LDB(B0, 0, 0); PG8_LDB(B1, 0, 1); PG8_SCHED; PG8_LDA(At, 0, 0); PG8_STAGE(PG8_SA(1, 1), a1 + hstep, voffA);
            PG8_WAIT_V(8); PG8_WAIT_L(0); PG8_BAR; PG8_MMA(0, 0, At, B0); PG8_MMA(0, 1, At, B1); PG8_BAR; PG8_SCHED;
            PG8_LDA(At, 0, 1); PG8_STAGE(PG8_SB(0, 0), b2, voffB); PG8_STAGE(PG8_SB(0, 1), b2 + hstep, voffB); PG8_STAGE(PG8_SA(0, 0), a2, voffA);
            PG8_WAIT_V(8); PG8_WAIT_L(0); PG8_BAR; PG8_MMA(1, 0, At, B0); PG8_MMA(1, 1, At, B1); PG8_BAR; PG8_SCHED;
            PG8_LDB(B0, 1, 0); PG8_LDB(B1, 1, 1); PG8_SCHED; PG8_LDA(At, 1, 0); PG8_STAGE(PG8_SA(0, 1), a2 + hstep, voffA);
            PG8_WAIT_V(8); PG8_WAIT_L(0); PG8_BAR; PG8_MMA(0, 0, At, B0); PG8_MMA(0, 1, At, B1); PG8_BAR; PG8_SCHED;
            PG8_LDA(At, 1, 1); PG8_STAGE(PG8_SB(1, 0), b3, voffB); PG8_STAGE(PG8_SB(1, 1), b3 + hstep, voffB); PG8_STAGE(PG8_SA(1, 0), a3, voffA);
            PG8_WAIT_V(8); PG8_WAIT_L(0); PG8_BAR; PG8_MMA(1, 0, At, B0); PG8_MMA(1, 1, At, B1); PG8_BAR; PG8_SCHED;
            } else {
            PG8_LDB(B0, 0, 0); PG8_SCHED; PG8_LDA(At, 0, 0); PG8_STAGE(PG8_SA(1, 1), a1 + hstep, voffA);
            PG8_WAIT_L(8); PG8_BAR; PG8_WAIT_L(0); PG8_MMA(0, 0, At, B0); PG8_BAR; PG8_SCHED;
            PG8_LDB(B1, 0, 1); PG8_STAGE(PG8_SB(0, 0), b2, voffB);
            PG8_BAR; PG8_WAIT_L(0); PG8_MMA(0, 1, At, B1); PG8_BAR;
            PG8_LDA(At, 0, 1); PG8_STAGE(PG8_SA(0, 0), a2, voffA);
            PG8_BAR; PG8_WAIT_L(0); PG8_MMA(1, 0, At, B0); PG8_BAR; PG8_SCHED;
            PG8_STAGE(PG8_SB(0, 1), b2 + hstep, voffB);
            PG8_WAIT_V(6); PG8_BAR; PG8_MMA(1, 1, At, B1); PG8_BAR;
            PG8_LDB(B0, 1, 0); PG8_SCHED; PG8_LDA(At, 1, 0); PG8_STAGE(PG8_SA(0, 1), a2 + hstep, voffA);
            PG8_WAIT_L(8); PG8_BAR; PG8_WAIT_L(0); PG8_MMA(0, 0, At, B0); PG8_BAR; PG8_SCHED;
            PG8_LDB(B1, 1, 1); PG8_STAGE(PG8_SB(1, 0), b3, voffB);
            PG8_BAR; PG8_WAIT_L(0); PG8_MMA(0, 1, At, B1); PG8_BAR;
            PG8_LDA(At, 1, 1); PG8_STAGE(PG8_SA(1, 0), a3, voffA);
            PG8_BAR; PG8_WAIT_L(0); PG8_MMA(1, 0, At, B0); PG8_BAR; PG8_SCHED;
            PG8_STAGE(PG8_SB(1, 1), b3 + hstep, voffB);
            PG8_WAIT_V(6); PG8_BAR; PG8_MMA(1, 1, At, B1); PG8_BAR;
            }
        }
        if constexpr (ALIGN_EPI) { if (wr == 0) PG8_BAR; }
        if constexpr (!Epi::AFTER_DRAIN) { E(acc, cur, wr, wc, fr, fq); S.done(cur); }
        if (!has_next) break;
#pragma unroll
        for (int a = 0; a < 2; ++a)
#pragma unroll
            for (int b = 0; b < 2; ++b)
#pragma unroll
                for (int m = 0; m < 4; ++m)
#pragma unroll
                    for (int n = 0; n < 2; ++n) acc[a][b][m][n] = (f32x4){0.f, 0.f, 0.f, 0.f};
        cur = nxt; cA = nA; cB = nB; ++ui;
        if constexpr (ALIGN_EPI) { if (wr == 1) PG8_BAR; }
    }
    PG8_WAIT_V(0);
    if constexpr (!ALIGN_EPI) { if (wr == 0) PG8_BAR; }
    PG8_BAR;
    if constexpr (Epi::AFTER_DRAIN) { E.fused(acc, cur, wr, wc, fr, fq, lds, wid, lane); S.done(cur); }
#undef PG8_SA
#undef PG8_SB
#undef PG8_STAGE
#undef PG8_LDA
#undef PG8_LDB
#undef PG8_MMA
#undef PG8_WAIT_V
#undef PG8_WAIT_L
#undef PG8_BAR
#undef PG8_SCHED
}
}
#define LAS __attribute__((address_space(3)))
typedef unsigned short bf16_t;
typedef short bf16x8 __attribute__((ext_vector_type(8)));
typedef float f32x4 __attribute__((ext_vector_type(4)));
typedef float f32x16 __attribute__((ext_vector_type(16)));
typedef unsigned u32x4 __attribute__((ext_vector_type(4)));
typedef unsigned u32x2 __attribute__((ext_vector_type(2)));

constexpr int NB = 8, S = 2048, D = 1024, DEPTH = 4, M = NB * S;
constexpr int INW = 2762, INP = 2816, FF = 2816, GU = 5632;
constexpr int C_FQ = 0, C_FK = 384, C_FV = 768, C_DQ = 1152, C_DK = 1408, C_DV = 1664, C_SQ = 1920, C_SK = 2304, C_SV = 2368, C_IQ = 2432, C_IK = 2688, C_FF = 2752, C_IW = 2758;
constexpr float EPS = 1e-6f, LOG2E = 1.4426950408889634f, NEGBIG = -1e30f;
constexpr int NWAVES = 8, NTHR = 512;
constexpr int LDS_BYTES = 147456;
constexpr int NPH = 1 + 7 * DEPTH;

constexpr size_t MiB = 1u << 20;
constexpr size_t WS_WIN = 0, WS_WOUT = 22 * MiB, WS_WGU = 30 * MiB, WS_WDN = 74 * MiB, WS_AB = 96 * MiB, WS_PROJ = 128 * MiB,
                 WS_FQ = 216 * MiB, WS_FK = 228 * MiB, WS_DQ = 240 * MiB, WS_DK = 248 * MiB, WS_SQ = 256 * MiB, WS_SK = 268 * MiB,
                 WS_IQ = 270 * MiB, WS_IK = 278 * MiB, WS_VT = 280 * MiB, WS_SIDE = 302 * MiB, WS_LOGF = 303 * MiB, WS_MASK = 304 * MiB,
                 WS_ROPE = 308 * MiB, WS_BAR = 309 * MiB, WS_XB = 310 * MiB, WS_SSQ = 342 * MiB, WS_CTR = 344 * MiB, WS_END = 345 * MiB;

struct Args { const float* in[19]; float* out; unsigned char* ws; float invf[12]; int ph_lo, ph_hi; };

struct Ctx {
    const Args& a; int wv;
    __device__ __forceinline__ const float* in(int i) const { const float* p = a.in[i]; asm volatile("" : "+s"(p)); return p; }
    __device__ __forceinline__ float* out() const { return a.out; }
#define CTX_PTR(name, T, off) __device__ __forceinline__ T* name() const { unsigned char* w = a.ws; asm volatile("" : "+s"(w)); return (T*)(w + (off)); }
    CTX_PTR(Win, bf16_t, WS_WIN) CTX_PTR(Wout, bf16_t, WS_WOUT) CTX_PTR(Wgu, bf16_t, WS_WGU) CTX_PTR(Wdn, bf16_t, WS_WDN) CTX_PTR(AB, bf16_t, WS_AB) CTX_PTR(PROJ, bf16_t, WS_PROJ)
    CTX_PTR(FQ, bf16_t, WS_FQ) CTX_PTR(FK, bf16_t, WS_FK) CTX_PTR(DQ, bf16_t, WS_DQ) CTX_PTR(DK, bf16_t, WS_DK) CTX_PTR(SQ, bf16_t, WS_SQ) CTX_PTR(SK, bf16_t, WS_SK)
    CTX_PTR(IQ, bf16_t, WS_IQ) CTX_PTR(IK, bf16_t, WS_IK) CTX_PTR(VT, bf16_t, WS_VT) CTX_PTR(SIDE, float, WS_SIDE) CTX_PTR(LOGF, float, WS_LOGF) CTX_PTR(ROPE, float, WS_ROPE)
    CTX_PTR(MASK, unsigned, WS_MASK) CTX_PTR(XB, bf16_t, WS_XB) CTX_PTR(SSQ, float, WS_SSQ) CTX_PTR(CTR, int, WS_CTR)
#undef CTX_PTR
};

__device__ __forceinline__ unsigned f2bf(float f) { unsigned u = __builtin_bit_cast(unsigned, f); return (u + 0x7fffu + ((u >> 16) & 1u)) >> 16; }
typedef float f32x2_t __attribute__((ext_vector_type(2))); typedef __bf16 bf16x2_t __attribute__((ext_vector_type(2)));
__device__ __forceinline__ unsigned pk2(float lo, float hi) { f32x2_t v = {lo, hi}; bf16x2_t b = __builtin_convertvector(v, bf16x2_t); return __builtin_bit_cast(unsigned, b); }
__device__ __forceinline__ float bf2f(bf16_t v) { return __builtin_bit_cast(float, (unsigned)v << 16); }
__device__ __forceinline__ float wave_sum(float v) {
#pragma unroll
    for (int o = 1; o < 64; o <<= 1) v += __shfl_xor(v, o);
    return v;
}
__device__ __forceinline__ float half_sum(float v) {
#pragma unroll
    for (int o = 1; o < 32; o <<= 1) v += __shfl_xor(v, o);
    return v;
}
__device__ __forceinline__ int lane_id() { unsigned m = ~0u; asm volatile("" : "+s"(m)); return (int)__builtin_amdgcn_mbcnt_hi(m, __builtin_amdgcn_mbcnt_lo(m, 0u)); }
__device__ __forceinline__ int otid(int wv) { int t = wv * 64 + lane_id(); asm volatile("" : "+v"(t)); return t; }
__device__ __forceinline__ int crow(int r, int hi) { return (r & 3) + 8 * (r >> 2) + 4 * hi; }

__device__ __forceinline__ float row_rs(const float* ssq, int row) {
    const f32x4* p = (const f32x4*)(ssq + (size_t)row * 16); const f32x4 a = p[0], b = p[1], c = p[2], d = p[3];
    const float s = (((a[0] + a[1]) + (a[2] + a[3])) + ((b[0] + b[1]) + (b[2] + b[3]))) + (((c[0] + c[1]) + (c[2] + c[3])) + ((d[0] + d[1]) + (d[2] + d[3])));
    return 1.0f / sqrtf(s * (1.f / D) + EPS);
}
struct EpiProj {
    static constexpr bool PERM = true, AFTER_DRAIN = false;
    bf16_t* O; float* side; const float* ssq;
    __device__ __forceinline__ void operator()(const pg8::f32x4 (&acc)[2][2][4][2], const pg8::Unit& u, int wr, int wc, int fr, int fq) const {
        const int row0 = u.pm * 256 + wr * 64 + fr, col0 = u.pn * 256 + wc * 32 + 8 * fq;
#pragma unroll
        for (int ai = 0; ai < 2; ++ai)
#pragma unroll
            for (int m = 0; m < 4; ++m) { const int row = row0 + ai * 128 + m * 16; bf16_t* rowp = O + (size_t)row * INP + col0;
                const float rs = row_rs(ssq, row);
#pragma unroll
                for (int bj = 0; bj < 2; ++bj) { const f32x4 v0 = acc[ai][bj][m][0] * rs, v1 = acc[ai][bj][m][1] * rs;
                    u32x4 w; w.x = pk2(v0[0], v0[1]); w.y = pk2(v0[2], v0[3]); w.z = pk2(v1[0], v1[1]); w.w = pk2(v1[2], v1[3]);
                    *(u32x4*)(rowp + bj * 128) = w;
                    const int cc = col0 + bj * 128; float* sp = side + (size_t)row * 16;
                    if (cc == 2752) { sp[0] = v0[0]; sp[1] = v0[1]; sp[2] = v0[2]; sp[3] = v0[3]; sp[4] = v1[0]; sp[5] = v1[1]; sp[8] = v1[2]; sp[9] = v1[3]; }
                    if (cc == 2760) { sp[10] = v0[0]; sp[11] = v0[1]; } } }
    }
};
struct EpiResid {
    static constexpr bool PERM = false, AFTER_DRAIN = false;
    const float* xin; float* xout; bf16_t* xb; float* ssq;
    __device__ __forceinline__ void operator()(const pg8::f32x4 (&acc)[2][2][4][2], const pg8::Unit& u, int wr, int wc, int fr, int fq) const {
        const int col0 = u.pn * 256 + wc * 32 + 4 * fq;
#pragma unroll
        for (int ai = 0; ai < 2; ++ai)
#pragma unroll
            for (int m = 0; m < 4; ++m) { const int row = u.pm * 256 + ai * 128 + wr * 64 + m * 16 + fr; const size_t off = (size_t)row * D + col0; float sq = 0.f;
#pragma unroll
                for (int bj = 0; bj < 2; ++bj)
#pragma unroll
                    for (int n = 0; n < 2; ++n) { const f32x4 bs = *(const f32x4*)(xin + off + bj * 128 + n * 16); const f32x4 v = bs + acc[ai][bj][m][n]; *(f32x4*)(xout + off + bj * 128 + n * 16) = v;
                        if (xb) { u32x2 w; w.x = pk2(v[0], v[1]); w.y = pk2(v[2], v[3]); *(u32x2*)(xb + off + bj * 128 + n * 16) = w; sq += (v[0] * v[0] + v[1] * v[1]) + (v[2] * v[2] + v[3] * v[3]); } }
                if (xb) { sq += __shfl_xor(sq, 16); sq += __shfl_xor(sq, 32); if (fq == 0) ssq[(size_t)row * 16 + u.pn * 4 + wc] = sq; }
                if (m & 1) asm volatile("" ::: "memory"); }
    }
};
struct EpiSwiglu {
    static constexpr bool PERM = true, AFTER_DRAIN = false;
    bf16_t* H; const float* ssq;
    __device__ __forceinline__ void operator()(const pg8::f32x4 (&acc)[2][2][4][2], const pg8::Unit& u, int wr, int wc, int fr, int fq) const {
        const int row0 = u.pm * 256 + wr * 64 + fr, col0 = u.pn * 128 + wc * 32 + 8 * fq;
#pragma unroll
        for (int ai = 0; ai < 2; ++ai)
#pragma unroll
            for (int m = 0; m < 4; ++m) { const int row = row0 + ai * 128 + m * 16; float hv[8];
                const float rs = row_rs(ssq, row);
#pragma unroll
                for (int n = 0; n < 2; ++n)
#pragma unroll
                    for (int i = 0; i < 4; ++i) { const float g = acc[ai][0][m][n][i] * rs, up = acc[ai][1][m][n][i] * rs; hv[4 * n + i] = g * __builtin_amdgcn_rcpf(1.f + __expf(-g)) * up; }
                u32x4 w; w.x = pk2(hv[0], hv[1]); w.y = pk2(hv[2], hv[3]); w.z = pk2(hv[4], hv[5]); w.w = pk2(hv[6], hv[7]);
                *(u32x4*)(H + (size_t)row * FF + col0) = w; }
    }
};

__device__ __forceinline__ void wt_item(const float* __restrict__ W, int K, int Nsrc, int Ndst, const float* __restrict__ gain, bf16_t* WT, int mode, int item, LAS float* scr, int lane) {
    const int nblk = Ndst / 64, kb = item / nblk, nb = item - kb * nblk, k0 = 64 * kb, n0 = 64 * nb;
    const int nd = n0 + 2 * (lane & 31);
    int sc;
    if (mode == 1) { const int j = nd >> 8, rr = nd & 255; sc = rr < 128 ? 128 * j + rr : FF + 128 * j + (rr - 128); }
    else if (mode == 2) sc = nd < 1152 ? nd : nd < 2752 ? nd + 6 : nd < 2758 ? nd - 1600 : nd < 2762 ? nd : -1;
    else sc = nd < Nsrc ? nd : -1;
    typedef float f32x2v __attribute__((ext_vector_type(2)));
    f32x2v v[32];
#pragma unroll
    for (int i = 0; i < 32; ++i) { const int kk = 2 * i + (lane >> 5); v[i] = (f32x2v){0.f, 0.f};
        if (sc >= 0) v[i] = *(const f32x2v*)(W + (size_t)(k0 + kk) * Nsrc + sc); }
#pragma unroll
    for (int i = 0; i < 32; ++i) { const int kk = 2 * i + (lane >> 5); float g = 1.f; if (gain) g = gain[k0 + kk];
        scr[kk * 65 + 2 * (lane & 31)] = v[i].x * g; scr[kk * 65 + 2 * (lane & 31) + 1] = v[i].y * g; }
    asm volatile("s_waitcnt lgkmcnt(0)" ::: "memory");
    const int c = lane & 7;
#pragma unroll
    for (int j = 0; j < 8; ++j) { const int n = (lane >> 3) + 8 * j; const LAS float* s = scr + (8 * c) * 65 + n;
        u32x4 o; o.x = pk2(s[0 * 65], s[1 * 65]); o.y = pk2(s[2 * 65], s[3 * 65]); o.z = pk2(s[4 * 65], s[5 * 65]); o.w = pk2(s[6 * 65], s[7 * 65]);
        *(u32x4*)(WT + (size_t)(n0 + n) * K + k0 + 8 * c) = o; }
    asm volatile("s_waitcnt lgkmcnt(0)" ::: "memory");
}

__device__ __forceinline__ void convert_layer(const Ctx& c, const int l, const int gw, const int NGW, LAS float* scr, const int lane) {
    constexpr int I_IN = 16 * (INP / 64), I_OUT = 16 * (D / 64), I_GU = 16 * (GU / 64), I_DN = (FF / 64) * (D / 64), I_L = I_IN + I_OUT + I_GU + I_DN;
#pragma unroll 1
    for (int it = gw; it < I_L; it += NGW) {
        int r = it;
        if (r < I_IN) { wt_item(c.in(2) + (size_t)l * D * INW, D, INW, INP, c.in(1) + l * D, c.Win() + (size_t)l * INP * D, 2, r, scr, lane); continue; } r -= I_IN;
        if (r < I_OUT) { wt_item(c.in(15) + (size_t)l * D * D, D, D, D, nullptr, c.Wout() + (size_t)l * D * D, 0, r, scr, lane); continue; } r -= I_OUT;
        if (r < I_GU) { wt_item(c.in(17) + (size_t)l * D * GU, D, GU, GU, c.in(16) + l * D, c.Wgu() + (size_t)l * GU * D, 1, r, scr, lane); continue; } r -= I_GU;
        wt_item(c.in(18) + (size_t)l * FF * D, FF, D, D, nullptr, c.Wdn() + (size_t)l * D * FF, 0, r, scr, lane);
    }
}

__device__ __forceinline__ void phase0(const Ctx& c, const Args& a, LAS unsigned char* L) {
    const int tid = otid(c.wv), lane = tid & 63, wave = tid >> 6;
    LAS float* scr = (LAS float*)(L + wave * 16640);
    const int gw = blockIdx.x * NWAVES + wave, NGW = gridDim.x * NWAVES;
    for (int l = 0; l < (gridDim.x == 256 ? 1 : DEPTH); ++l) convert_layer(c, l, gw, NGW, scr, lane);
    { float* ssq = c.SSQ(); bf16_t* xb = c.XB(); const float* x = c.in(0);
      for (int m = gw; m < M; m += NGW) {
        const f32x4* xr = (const f32x4*)(x + (size_t)m * D) + lane;
        f32x4 v[4]; float ss = 0.f;
#pragma unroll
        for (int j = 0; j < 4; ++j) { v[j] = xr[64 * j]; ss += (v[j].x * v[j].x + v[j].y * v[j].y) + (v[j].z * v[j].z + v[j].w * v[j].w); }
        ss = wave_sum(ss);
        u32x2* o8 = (u32x2*)(xb + (size_t)m * D) + lane;
#pragma unroll
        for (int j = 0; j < 4; ++j) { u32x2 w; w.x = pk2(v[j].x, v[j].y); w.y = pk2(v[j].z, v[j].w); o8[64 * j] = w; }
        if (lane < 16) ssq[(size_t)m * 16 + lane] = lane == 0 ? ss : 0.f;
      } }
    if (blockIdx.x == 0 && tid < DEPTH) c.CTR()[64 * tid] = 0;
    const int gt = blockIdx.x * NTHR + tid, NGT = gridDim.x * NTHR;
    for (int e = gt; e < S * 12; e += NGT) {
        const int s = e / 12, i = e - s * 12;
        const float angf = (float)s * a.invf[i];
        const double ang = (double)angf;
        const double k = __builtin_rint(ang * 0.63661977236758134308);
        const double r = __builtin_fma(-k, 1.57079632679489661923, ang) - k * 6.123233995736766e-17;
        const double r2 = r * r;
        double sn = -1.0 / 6227020800.0; sn = sn * r2 + 1.0 / 39916800.0; sn = sn * r2 - 1.0 / 362880.0; sn = sn * r2 + 1.0 / 5040.0; sn = sn * r2 - 1.0 / 120.0; sn = sn * r2 + 1.0 / 6.0; sn = r - r * r2 * sn;
        double cs = 1.0 / 87178291200.0; cs = cs * r2 - 1.0 / 479001600.0; cs = cs * r2 + 1.0 / 3628800.0; cs = cs * r2 - 1.0 / 40320.0; cs = cs * r2 + 1.0 / 720.0; cs = cs * r2 - 1.0 / 24.0; cs = cs * r2 + 0.5; cs = 1.0 - r2 * cs;
        const int q = ((int)k) & 3;
        const double cv = (q == 0) ? cs : (q == 1) ? -sn : (q == 2) ? -cs : sn;
        const double sv = (q == 0) ? sn : (q == 1) ? cs : (q == 2) ? -sn : -cs;
        c.ROPE()[2 * e] = (float)cv; c.ROPE()[2 * e + 1] = (float)sv;
    }
}

__device__ __forceinline__ void norm_phase(const Ctx& c, const float* x, bf16_t* xn) {
    const int tid = otid(c.wv), lane = tid & 63, wave = tid >> 6;
    const int gw = blockIdx.x * NWAVES + wave, NGW = gridDim.x * NWAVES;
    for (int m = gw; m < M; m += NGW) {
        const f32x4* xr = (const f32x4*)(x + (size_t)m * D) + lane;
        f32x4 v[4]; float ss = 0.f;
#pragma unroll
        for (int j = 0; j < 4; ++j) { v[j] = xr[64 * j]; ss += (v[j].x * v[j].x + v[j].y * v[j].y) + (v[j].z * v[j].z + v[j].w * v[j].w); }
        const float r = 1.0f / sqrtf(wave_sum(ss) * (1.f / D) + EPS);
        u32x2* o8 = (u32x2*)(xn + (size_t)m * D) + lane;
#pragma unroll
        for (int j = 0; j < 4; ++j) { u32x2 w; w.x = pk2(v[j].x * r, v[j].y * r); w.y = pk2(v[j].z * r, v[j].w * r); o8[64 * j] = w; }
    }
}

template <int KIND>
__device__ __forceinline__ void prep_kind(const Ctx& c, int l, int gw, int NGW, int lane) {
    constexpr int NSLOT = KIND == 0 ? 12 : KIND == 1 ? 8 : KIND == 2 ? 7 : 5, NQ = KIND == 0 ? 6 : KIND == 1 ? 4 : KIND == 2 ? 6 : 4;
    constexpr int UNR = 4, NRT = KIND == 1 ? 2 : KIND >= 2 ? 4 : 1;
    const int sub = lane & 7;
    const float QS64 = 0.125f * LOG2E, QS32 = 0.17677669529663687f * LOG2E;
    const bf16_t* proj = c.PROJ(); const float* rope = c.ROPE();
    f32x4 gq0 = {1.f, 1.f, 1.f, 1.f}, gq1 = gq0, gk0 = gq0, gk1 = gq0;
    if (KIND != 3) { const float* gq = (KIND == 0 ? c.in(4) + l * 64 : KIND == 1 ? c.in(6) + l * 32 : c.in(13) + l * 64) + (KIND == 1 ? 8 * (sub & 3) : 8 * sub);
        const float* gk = (KIND == 0 ? c.in(5) + l * 64 : KIND == 1 ? c.in(7) + l * 32 : c.in(14) + l * 64) + (KIND == 1 ? 8 * (sub & 3) : 8 * sub);
        gq0 = *(const f32x4*)gq; gq1 = *(const f32x4*)(gq + 4); gk0 = *(const f32x4*)gk; gk1 = *(const f32x4*)(gk + 4); }
    for (int it0 = gw * 8; it0 < M * NSLOT; it0 += NGW * 8 * UNR) {
        u32x4 raw[UNR]; f32x4 rt[UNR][NRT];
#pragma unroll
        for (int u = 0; u < UNR; ++u) if (it0 + u * NGW * 8 < M * NSLOT) {
            const int it = it0 + u * NGW * 8 + (lane >> 3), m = it / NSLOT, j = it - m * NSLOT, s = m % S;
            const int scol = KIND == 0 ? (j < 6 ? C_FQ + 64 * j : C_FK + 64 * (j - 6)) : KIND == 1 ? (j < 4 ? C_DQ + 64 * j : C_DK + 64 * (j - 4)) : KIND == 2 ? (j < 6 ? C_SQ + 64 * j : C_SK) : (j < 4 ? C_IQ + 64 * j : C_IK);
            raw[u] = __builtin_nontemporal_load((const u32x4*)(proj + (size_t)m * INP + scol + 8 * sub));
            if (KIND == 1) { rt[u][0] = *(const f32x4*)(rope + (size_t)s * 24 + 16); rt[u][NRT - 1] = *(const f32x4*)(rope + (size_t)s * 24 + 20); }
            if (KIND >= 2) {
#pragma unroll
                for (int q = 0; q < NRT; ++q) rt[u][q] = *(const f32x4*)(rope + (size_t)s * 24 + 4 * q); }
        }
#pragma unroll
        for (int u = 0; u < UNR; ++u) if (it0 + u * NGW * 8 < M * NSLOT) {
            const int it = it0 + u * NGW * 8 + (lane >> 3), m = it / NSLOT, j = it - m * NSLOT, b = m / S, s = m % S;
            bf16_t* dst; float qs = 1.f;
            if (KIND == 0) { if (j < 6) { dst = c.FQ() + ((size_t)(b * 6 + j) * S + s) * 64; qs = QS64; } else dst = c.FK() + ((size_t)(b * 6 + j - 6) * S + s) * 64; }
            else if (KIND == 1) { if (j < 4) { dst = c.DQ() + ((size_t)(b * 4 + j) * S + s) * 64; qs = QS32; } else dst = c.DK() + ((size_t)(b * 4 + j - 4) * S + s) * 64; }
            else if (KIND == 2) { if (j < 6) { dst = c.SQ() + ((size_t)(b * 6 + j) * S + s) * 64; qs = QS64; } else dst = c.SK() + (size_t)m * 64; }
            else { if (j < 4) dst = c.IQ() + (size_t)m * 256 + 64 * j; else dst = c.IK() + (size_t)m * 64; }
            float v[8];
#pragma unroll
            for (int i = 0; i < 4; ++i) { v[2 * i] = __builtin_bit_cast(float, raw[u][i] << 16); v[2 * i + 1] = __builtin_bit_cast(float, raw[u][i] & 0xffff0000u); }
            if (KIND != 3) {
                float ss = 0.f;
#pragma unroll
                for (int i = 0; i < 8; ++i) ss += v[i] * v[i];
                ss += __shfl_xor(ss, 1); ss += __shfl_xor(ss, 2); if (KIND != 1) ss += __shfl_xor(ss, 4);
                const float r = 1.0f / sqrtf(ss * (KIND == 1 ? 1.f / 32.f : 1.f / 64.f) + EPS);
                const f32x4 g0 = j < NQ ? gq0 : gk0, g1 = j < NQ ? gq1 : gk1;
#pragma unroll
                for (int i = 0; i < 4; ++i) { v[i] *= r * g0[i]; v[4 + i] *= r * g1[i]; }
            }
            if (KIND == 1) {
                if ((sub & 3) == 0) { const f32x4 t0 = rt[u][0], t1 = rt[u][NRT - 1];
                    const float cs[4] = {t0[0], t0[2], t1[0], t1[2]}, sn[4] = {t0[1], t0[3], t1[1], t1[3]};
#pragma unroll
                    for (int i = 0; i < 4; ++i) { const float x1 = v[i], x2 = v[4 + i]; v[i] = x1 * cs[i] - x2 * sn[i]; v[4 + i] = x2 * cs[i] + x1 * sn[i]; } }
            } else if (KIND >= 2) {
                float p[8];
#pragma unroll
                for (int i = 0; i < 8; ++i) p[i] = __shfl_xor(v[i], 1);
                if (sub < 2) { const float sg = sub == 0 ? -1.f : 1.f;
#pragma unroll
                    for (int q = 0; q < 4; ++q) { const f32x4 t = rt[u][q < NRT ? q : 0];
                        v[2 * q] = v[2 * q] * t[0] + sg * p[2 * q] * t[1]; v[2 * q + 1] = v[2 * q + 1] * t[2] + sg * p[2 * q + 1] * t[3]; } }
            }
            u32x4 w; w.x = pk2(v[0] * qs, v[1] * qs); w.y = pk2(v[2] * qs, v[3] * qs); w.z = pk2(v[4] * qs, v[5] * qs); w.w = pk2(v[6] * qs, v[7] * qs);
            *(u32x4*)(dst + 8 * sub) = w;
        }
    }
}
__device__ __forceinline__ void prep_phase(const Ctx& c, int l, LAS unsigned char* L) {
    const int tid = otid(c.wv), lane = tid & 63, wave = tid >> 6;
    const int gw = blockIdx.x * NWAVES + wave, NGW = gridDim.x * NWAVES;
    prep_kind<0>(c, l, gw, NGW, lane);
    prep_kind<1>(c, l, gw, NGW, lane);
    prep_kind<2>(c, l, gw, NGW, lane);
    prep_kind<3>(c, l, gw, NGW, lane);
    for (int e = blockIdx.x * NTHR + tid; e < NB * 6 * S; e += gridDim.x * NTHR) {
        const int s = e % S, h = (e / S) % 6, b = e / (6 * S);
        const float z = c.SIDE()[(size_t)(b * S + s) * 16 + h] + c.in(3)[l * 6 + h];
        c.LOGF()[e] = fminf(z, 0.f) - log1pf(__expf(-fabsf(z)));
    }
    LAS unsigned char* T = L + wave * 8704;
    for (int it = gw; it < NB * 11 * (S / 64); it += NGW) {
        const int blk = it % (S / 64), slot = (it / (S / 64)) % 11, b = it / (11 * (S / 64));
        const int vcol = slot < 6 ? C_FV + 64 * slot : slot < 10 ? C_DV + 64 * (slot - 6) : C_SV;
        const bf16_t* src = c.PROJ() + ((size_t)(b * S + 64 * blk)) * INP + vcol + 8 * (lane & 7);
        u32x4 rv[8];
#pragma unroll
        for (int i = 0; i < 8; ++i) rv[i] = __builtin_nontemporal_load((const u32x4*)(src + (size_t)(8 * i + (lane >> 3)) * INP));
#pragma unroll
        for (int i = 0; i < 8; ++i) { LAS u32x2* tp = (LAS u32x2*)(T + (8 * i + (lane >> 3)) * 136 + 16 * (lane & 7)); u32x2 a0; a0.x = rv[i].x; a0.y = rv[i].y; u32x2 a1; a1.x = rv[i].z; a1.y = rv[i].w; tp[0] = a0; tp[1] = a1; }
        asm volatile("s_waitcnt lgkmcnt(0)" ::: "memory");
        unsigned o[32];
#pragma unroll
        for (int i = 0; i < 32; ++i) o[i] = 0u;
#pragma unroll
        for (int kv = 0; kv < 64; ++kv) { const int pos = (kv & 32) + 16 * ((kv >> 2) & 1) + (kv & 3) + 4 * ((kv & 31) >> 3);
            const unsigned v = *(const LAS bf16_t*)(T + kv * 136 + 2 * lane); o[pos >> 1] |= v << (16 * (pos & 1)); }
        u32x4* dstp = (u32x4*)(c.VT() + ((size_t)(b * 11 + slot) * 64 + lane) * S + 64 * blk);
#pragma unroll
        for (int q = 0; q < 8; ++q) { u32x4 w; w.x = o[4 * q]; w.y = o[4 * q + 1]; w.z = o[4 * q + 2]; w.w = o[4 * q + 3]; dstp[q] = w; }
        asm volatile("s_waitcnt lgkmcnt(0)" ::: "memory");
    }
}

constexpr int SC_PITCH = 2052;
__device__ __forceinline__ unsigned f2key(float v) { const unsigned u = __builtin_bit_cast(unsigned, v); return (u & 0x80000000u) ? ~u : (u | 0x80000000u); }
__device__ __forceinline__ unsigned wave_max_u(unsigned v) {
#pragma unroll
    for (int o = 1; o < 64; o <<= 1) { const unsigned n = (unsigned)__shfl_xor((int)v, o); v = n > v ? n : v; }
    return v;
}
__device__ __forceinline__ unsigned wave_min_u(unsigned v) {
#pragma unroll
    for (int o = 1; o < 64; o <<= 1) { const unsigned n = (unsigned)__shfl_xor((int)v, o); v = n < v ? n : v; }
    return v;
}
__device__ __forceinline__ unsigned wave_sum_u(unsigned v) {
    v += (unsigned)__builtin_amdgcn_update_dpp(0, (int)v, 0xB1, 0xf, 0xf, true);
    v += (unsigned)__builtin_amdgcn_update_dpp(0, (int)v, 0x4E, 0xf, 0xf, true);
    v += (unsigned)__builtin_amdgcn_update_dpp(0, (int)v, 0x141, 0xf, 0xf, true);
    v += (unsigned)__builtin_amdgcn_update_dpp(0, (int)v, 0x140, 0xf, 0xf, true);
    return (unsigned)__builtin_amdgcn_readlane((int)v, 0) + (unsigned)__builtin_amdgcn_readlane((int)v, 16) + (unsigned)__builtin_amdgcn_readlane((int)v, 32) + (unsigned)__builtin_amdgcn_readlane((int)v, 48);
}
__device__ __forceinline__ void idx_unit(const Ctx& c, int b, int blk, LAS unsigned char* L) {
    const int tid = otid(c.wv), lane = tid & 63, wave = __builtin_amdgcn_readfirstlane(tid >> 6), q = lane & 15, quad = lane >> 4;
    const int t0 = 16 * blk;
    LAS float* SC = (LAS float*)L;
    {
        const bf16_t* iqp = c.IQ() + (size_t)(b * S + t0 + q) * 256 + 8 * quad;
        bf16x8 bq[4][2];
#pragma unroll
        for (int h = 0; h < 4; ++h)
#pragma unroll
            for (int ks = 0; ks < 2; ++ks) bq[h][ks] = *(const bf16x8*)(iqp + 64 * h + 32 * ks);
        const f32x4 w = *(const f32x4*)(c.SIDE() + (size_t)(b * S + t0 + q) * 16 + 8);
        const bf16_t* ikb = c.IK() + (size_t)(b * S + q) * 64 + 8 * quad;
#pragma unroll 1
        for (int tb = 4 * wave; tb <= blk; tb += 4 * NWAVES) {
            bf16x8 a0[4], a1[4];
#pragma unroll
            for (int u = 0; u < 4; ++u) { const int tile = tb + u <= blk ? tb + u : blk; const bf16_t* ikp = ikb + (size_t)tile * 1024; a0[u] = *(const bf16x8*)ikp; a1[u] = *(const bf16x8*)(ikp + 32); }
#pragma unroll
            for (int u = 0; u < 4; ++u) if (tb + u <= blk) {
                f32x4 sc = {0.f, 0.f, 0.f, 0.f};
#pragma unroll
                for (int h = 0; h < 4; ++h) { f32x4 acc = {0.f, 0.f, 0.f, 0.f};
                    acc = __builtin_amdgcn_mfma_f32_16x16x32_bf16(a0[u], bq[h][0], acc, 0, 0, 0);
                    acc = __builtin_amdgcn_mfma_f32_16x16x32_bf16(a1[u], bq[h][1], acc, 0, 0, 0);
#pragma unroll
                    for (int r = 0; r < 4; ++r) sc[r] += w[h] * fmaxf(acc[r], 0.f); }
                *(LAS f32x4*)(SC + q * SC_PITCH + 16 * (tb + u) + 4 * quad) = sc;
            }
        }
    }
    __syncthreads();
#pragma unroll 1
    for (int rr = 0; rr < 2; ++rr) {
        const int row = 2 * wave + rr, t = t0 + row;
        const LAS float* srow = SC + row * SC_PITCH;
        unsigned key[32];
#pragma unroll
        for (int j = 0; j < 32; ++j) key[j] = __builtin_bit_cast(unsigned, srow[64 * j + lane]);
#pragma unroll
        for (int j = 0; j < 32; ++j) { const unsigned k = f2key(__builtin_bit_cast(float, key[j]) + 0.0f); key[j] = (64 * j + lane <= t) ? k : 0u; }
        unsigned W = 0u;
        if (t + 1 > 256) {
            unsigned kmx = 0u, kmn = 0xffffffffu;
#pragma unroll
            for (int j = 0; j < 32; ++j) { kmx = key[j] > kmx ? key[j] : kmx; const unsigned kk = key[j] ? key[j] : 0xffffffffu; kmn = kk < kmn ? kk : kmn; }
            unsigned lo, hi, cge;
            {
            lo = __builtin_amdgcn_readfirstlane(wave_min_u(kmn)); hi = __builtin_amdgcn_readfirstlane(wave_max_u(kmx)) + 1u; cge = 0xffffffffu; asm volatile("" : "+v"(kmn), "+v"(kmx));
            while (hi - lo > 1u) {
                const unsigned mid = lo + ((hi - lo) >> 1);
                unsigned c0 = 0u, c1 = 0u, c2 = 0u, c3 = 0u;
#pragma unroll
                for (int j = 0; j < 32; j += 4) { unsigned long long m0, m1, m2, m3;
                    asm("v_cmp_ge_u32_e64 %4, %8, %12\n\tv_cmp_ge_u32_e64 %5, %9, %12\n\tv_cmp_ge_u32_e64 %6, %10, %12\n\tv_cmp_ge_u32_e64 %7, %11, %12\n\t"
                        "v_addc_co_u32_e64 %0, %4, %0, 0, %4\n\tv_addc_co_u32_e64 %1, %5, %1, 0, %5\n\tv_addc_co_u32_e64 %2, %6, %2, 0, %6\n\tv_addc_co_u32_e64 %3, %7, %3, 0, %7"
                        : "+v"(c0), "+v"(c1), "+v"(c2), "+v"(c3), "=&s"(m0), "=&s"(m1), "=&s"(m2), "=&s"(m3)
                        : "v"(key[j]), "v"(key[j + 1]), "v"(key[j + 2]), "v"(key[j + 3]), "s"(mid)); }
                const unsigned cnt = wave_sum_u((c0 + c1) + (c2 + c3));
                if (cnt >= 256u) { lo = mid; cge = cnt; if (cnt == 256u) break; } else hi = mid;
            }
            }
            const unsigned T = lo;
            if (cge == 256u) {
#pragma unroll
                for (int j = 31; j >= 0; --j) W = (W << 1) | ((key[j] >= T) ? 1u : 0u);
            } else {
                unsigned cl = 0u;
#pragma unroll
                for (int j = 0; j < 32; ++j) cl += (key[j] > T) ? 1u : 0u;
                const unsigned need = 256u - wave_sum_u(cl);
                unsigned running = 0u; const unsigned long long ltmask = (1ull << lane) - 1ull;
#pragma unroll
                for (int j = 0; j < 32; ++j) { const unsigned long long eq = __ballot(key[j] == T);
                    const unsigned rank = running + (unsigned)__popcll(eq & ltmask);
                    const bool take = key[j] > T || (key[j] == T && rank < need);
                    running += (unsigned)__popcll(eq);
                    W |= (take ? 1u : 0u) << j; }
            }
        } else {
#pragma unroll
            for (int j = 0; j < 32; ++j) W |= (key[j] != 0u ? 1u : 0u) << j;
        }
        c.MASK()[(size_t)(b * S + t) * 64 + lane] = W;
    }
    __syncthreads();
}

constexpr int AT_KB0 = 0, AT_KB1 = 18432, AT_VB0 = 36864, AT_VB1 = 54272, AT_CUM = 71680, AT_SCR = 79872;
constexpr int AT_KP = 144, AT_VP = 272;
template <int TYPE>
__device__ __forceinline__ void att_qk(f32x16 (&p)[2], const LAS unsigned char* Kb, const LAS float* CUM, const int j, const int sub, const int mp, const int r32, const int hi, const float cq, const bf16x8 (&qr)[4]) {
    constexpr int NMAP = TYPE == 1 ? 2 : 1, KS = 4 / NMAP;
    if (TYPE == 0) {
#pragma unroll
        for (int g = 0; g < 4; ++g) { const f32x4 c0 = *(const LAS f32x4*)(CUM + 64 * j + 8 * g + 4 * hi), c1 = *(const LAS f32x4*)(CUM + 64 * j + 32 + 8 * g + 4 * hi);
#pragma unroll
            for (int i = 0; i < 4; ++i) { p[0][4 * g + i] = cq - c0[i]; p[1][4 * g + i] = cq - c1[i]; } }
    } else {
#pragma unroll
        for (int r = 0; r < 16; ++r) { p[0][r] = 0.f; p[1][r] = 0.f; }
    }
#pragma unroll
    for (int ks = 0; ks < KS; ++ks) { const int d0 = mp * KS + ks;
        const bf16x8 a0 = *(const LAS bf16x8*)(Kb + (sub * 64 + r32) * AT_KP + d0 * 32 + hi * 16);
        const bf16x8 a1 = *(const LAS bf16x8*)(Kb + (sub * 64 + 32 + r32) * AT_KP + d0 * 32 + hi * 16);
        p[0] = __builtin_amdgcn_mfma_f32_32x32x16_bf16(a0, qr[d0], p[0], 0, 0, 0);
        p[1] = __builtin_amdgcn_mfma_f32_32x32x16_bf16(a1, qr[d0], p[1], 0, 0, 0); }
}
template <int TYPE, bool BAND>
__device__ __forceinline__ void att_sm(f32x16 (&p)[2], u32x4 (&pw)[2][2], float& lr, const int j, const int qb, const int tq, const int hi, const u32x4 (&mk0)[4], const u32x4 (&mk1)[4]) {
    if (TYPE != 2) {
        if (BAND) { const int jb = j - 4 * qb;
            if (jb >= 0) { const int base = tq - 64 * j - 4 * hi;
#pragma unroll
                for (int r = 0; r < 16; ++r) { const int kk = (r & 3) + 8 * (r >> 2); if (kk > base) p[0][r] = NEGBIG; if (kk + 32 > base) p[1][r] = NEGBIG; } } }
    } else {
        const unsigned bitj = 1u << j;
#pragma unroll
        for (int r = 0; r < 16; ++r) { if (!(mk0[r >> 2][r & 3] & bitj)) p[0][r] = NEGBIG; if (!(mk1[r >> 2][r & 3] & bitj)) p[1][r] = NEGBIG; }
    }
    float ls = 0.f;
#pragma unroll
    for (int r = 0; r < 16; ++r) { p[0][r] = __builtin_amdgcn_exp2f(p[0][r]); p[1][r] = __builtin_amdgcn_exp2f(p[1][r]); ls += p[0][r] + p[1][r]; }
    lr += ls;
#pragma unroll
    for (int pp = 0; pp < 2; ++pp)
#pragma unroll
        for (int cc = 0; cc < 2; ++cc) { u32x4 w;
            w.x = pk2(p[pp][8 * cc + 0], p[pp][8 * cc + 1]); w.y = pk2(p[pp][8 * cc + 2], p[pp][8 * cc + 3]);
            w.z = pk2(p[pp][8 * cc + 4], p[pp][8 * cc + 5]); w.w = pk2(p[pp][8 * cc + 6], p[pp][8 * cc + 7]); pw[pp][cc] = w; }
}
__device__ __forceinline__ void att_pv(f32x16 (&o)[2], const u32x4 (&pw)[2][2], const LAS unsigned char* Vb, const int sub, const int r32, const int hi) {
#pragma unroll
    for (int pp = 0; pp < 2; ++pp)
#pragma unroll
        for (int cc = 0; cc < 2; ++cc)
#pragma unroll
            for (int db = 0; db < 2; ++db) {
                const bf16x8 av = *(const LAS bf16x8*)(Vb + (32 * db + r32) * AT_VP + sub * 128 + pp * 64 + hi * 32 + cc * 16);
                o[db] = __builtin_amdgcn_mfma_f32_32x32x16_bf16(av, __builtin_bit_cast(bf16x8, pw[pp][cc]), o[db], 0, 0, 0); }
}
template <int TYPE, bool BAND>
__device__ __forceinline__ void att_step(const LAS unsigned char* Kb, const LAS unsigned char* Vb, const LAS float* CUM, const int jj, const int qb, const int wave, const int tq, const int r32, const int hi,
                                         const float cq, const bf16x8 (&qr)[4], const u32x4 (&mk0)[4], const u32x4 (&mk1)[4], float (&lrun)[TYPE == 1 ? 2 : 1], f32x16 (&o)[TYPE == 1 ? 2 : 1][2]) {
    constexpr int NMAP = TYPE == 1 ? 2 : 1;
#pragma unroll
    for (int mp = 0; mp < NMAP; ++mp) {
        if (!BAND && TYPE == 0) {
            f32x16 pA[2], pB[2]; u32x4 wA[2][2], wB[2][2];
            att_qk<TYPE>(pA, Kb, CUM, 2 * jj, 0, mp, r32, hi, cq, qr);
            __builtin_amdgcn_sched_barrier(0);
            att_qk<TYPE>(pB, Kb, CUM, 2 * jj + 1, 1, mp, r32, hi, cq, qr);
            att_sm<TYPE, false>(pA, wA, lrun[mp], 2 * jj, qb, tq, hi, mk0, mk1);
            __builtin_amdgcn_sched_barrier(0);
            att_pv(o[mp], wA, Vb, 0, r32, hi);
            att_sm<TYPE, false>(pB, wB, lrun[mp], 2 * jj + 1, qb, tq, hi, mk0, mk1);
            __builtin_amdgcn_sched_barrier(0);
            att_pv(o[mp], wB, Vb, 1, r32, hi);
            __builtin_amdgcn_sched_barrier(0);
        } else {
#pragma unroll
            for (int sub = 0; sub < 2; ++sub) { const int j = 2 * jj + sub, jb = j - 4 * qb;
                const bool skip = BAND && (jb >= 0) && (64 * jb > 32 * wave + 31);
                if (!skip) { f32x16 pA[2]; u32x4 wA[2][2];
                    att_qk<TYPE>(pA, Kb, CUM, j, sub, mp, r32, hi, cq, qr);
                    att_sm<TYPE, BAND>(pA, wA, lrun[mp], j, qb, tq, hi, mk0, mk1);
                    att_pv(o[mp], wA, Vb, sub, r32, hi); }
                __builtin_amdgcn_sched_barrier(0); }
        }
    }
}

template <int TYPE>
__device__ __forceinline__ void attn_unit(const Ctx& c, int l, int b, int h, int qb, LAS unsigned char* L) {
    constexpr int NMAP = TYPE == 1 ? 2 : 1;
    const int tid = otid(c.wv), lane = tid & 63, wave = __builtin_amdgcn_readfirstlane(tid >> 6), r32 = lane & 31, hi = lane >> 5;
    const bf16_t *Qp, *Kp, *Vp; int ocol;
    if (TYPE == 0) { Qp = c.FQ() + (size_t)(b * 6 + h) * S * 64; Kp = c.FK() + (size_t)(b * 6 + h) * S * 64; Vp = c.VT() + (size_t)(b * 11 + h) * 64 * S; ocol = 64 * h; }
    else if (TYPE == 1) { Qp = c.DQ() + (size_t)(b * 4 + h) * S * 64; Kp = c.DK() + (size_t)(b * 4 + h) * S * 64; Vp = c.VT() + (size_t)(b * 11 + 6 + h) * 64 * S; ocol = 384 + 64 * h; }
    else { Qp = c.SQ() + (size_t)(b * 6 + h) * S * 64; Kp = c.SK() + (size_t)b * S * 64; Vp = c.VT() + (size_t)(b * 11 + 10) * 64 * S; ocol = 640 + 64 * h; }
    const int q0 = 256 * qb, tq = q0 + 32 * wave + r32, ns = 2 * (qb + 1);
    const bf16_t* kg0 = Kp + (size_t)(tid >> 3) * 64 + (tid & 7) * 8;
    const bf16_t* vg0 = Vp + (size_t)(tid >> 4) * S + (tid & 15) * 8;
    const unsigned ksoff = (tid >> 3) * AT_KP + (tid & 7) * 16, vsoff = (tid >> 4) * AT_VP + (tid & 15) * 16;
    u32x4 kreg[2], vreg[2];
    kreg[0] = *(const u32x4*)kg0; kreg[1] = *(const u32x4*)(kg0 + 64 * 64); vreg[0] = *(const u32x4*)vg0; vreg[1] = *(const u32x4*)(vg0 + (size_t)32 * S);
    bf16x8 qr[4];
#pragma unroll
    for (int d0 = 0; d0 < 4; ++d0) qr[d0] = *(const bf16x8*)(Qp + (size_t)tq * 64 + d0 * 16 + hi * 8);
    u32x4 mk0[4], mk1[4];
#pragma unroll
    for (int g = 0; g < 4; ++g) { mk0[g] = (u32x4){0u, 0u, 0u, 0u}; mk1[g] = (u32x4){0u, 0u, 0u, 0u}; }
    if (TYPE == 2) { const unsigned* mrow = c.MASK() + (size_t)(b * S + tq) * 64 + 4 * hi;
#pragma unroll
        for (int g = 0; g < 4; ++g) { mk0[g] = *(const u32x4*)(mrow + 8 * g); mk1[g] = *(const u32x4*)(mrow + 32 + 8 * g); } }
    LAS float* CUM = (LAS float*)(L + AT_CUM);
    if (TYPE == 0) {
        LAS float* SCR = (LAS float*)(L + AT_SCR);
        const f32x4 lf = *(const f32x4*)(c.LOGF() + (size_t)(b * 6 + h) * S + 4 * tid);
        const float a0 = lf[0], a1 = a0 + lf[1], a2 = a1 + lf[2], a3 = a2 + lf[3];
        float incl = a3;
#pragma unroll 1
        for (int off = 1; off < 64; off <<= 1) { const float n = __shfl_up(incl, off); if (lane >= off) incl += n; }
        if (lane == 63) SCR[wave] = incl;
        __syncthreads();
        float base = 0.f;
#pragma unroll
        for (int w = 0; w < NWAVES; ++w) if (w < wave) base += SCR[w];
        const float ex = incl - a3 + base;
        f32x4 cv; cv[0] = (ex + a0) * LOG2E; cv[1] = (ex + a1) * LOG2E; cv[2] = (ex + a2) * LOG2E; cv[3] = (ex + a3) * LOG2E;
        *(LAS f32x4*)(CUM + 4 * tid) = cv;
    }
    *(LAS u32x4*)(L + AT_KB0 + ksoff) = kreg[0]; *(LAS u32x4*)(L + AT_KB0 + ksoff + 64 * AT_KP) = kreg[1];
    *(LAS u32x4*)(L + AT_VB0 + vsoff) = vreg[0]; *(LAS u32x4*)(L + AT_VB0 + vsoff + 32 * AT_VP) = vreg[1];
    __syncthreads();
    float cq = 0.f; if (TYPE == 0) cq = CUM[tq];
    float lrun[NMAP]; f32x16 o[NMAP][2];
#pragma unroll
    for (int mp = 0; mp < NMAP; ++mp) { lrun[mp] = 0.f;
#pragma unroll
        for (int r = 0; r < 16; ++r) { o[mp][0][r] = 0.f; o[mp][1][r] = 0.f; } }
#pragma unroll 1
    for (int jj = 0; jj < ns; ++jj) {
        const int cur = jj & 1;
        if (jj + 1 < ns) { const bf16_t* kg = kg0 + (size_t)(jj + 1) * 128 * 64; const bf16_t* vg = vg0 + (size_t)(jj + 1) * 128;
            kreg[0] = *(const u32x4*)kg; kreg[1] = *(const u32x4*)(kg + 64 * 64); vreg[0] = *(const u32x4*)vg; vreg[1] = *(const u32x4*)(vg + (size_t)32 * S); }
        const LAS unsigned char* Kb = L + (cur ? AT_KB1 : AT_KB0);
        const LAS unsigned char* Vb = L + (cur ? AT_VB1 : AT_VB0);
        if (jj + 2 < ns) att_step<TYPE, false>(Kb, Vb, CUM, jj, qb, wave, tq, r32, hi, cq, qr, mk0, mk1, lrun, o);
        else att_step<TYPE, true>(Kb, Vb, CUM, jj, qb, wave, tq, r32, hi, cq, qr, mk0, mk1, lrun, o);
        if (jj + 1 < ns) { LAS unsigned char* Kn = L + (cur ? AT_KB0 : AT_KB1); LAS unsigned char* Vn = L + (cur ? AT_VB0 : AT_VB1);
            *(LAS u32x4*)(Kn + ksoff) = kreg[0]; *(LAS u32x4*)(Kn + ksoff + 64 * AT_KP) = kreg[1]; *(LAS u32x4*)(Vn + vsoff) = vreg[0]; *(LAS u32x4*)(Vn + vsoff + 32 * AT_VP) = vreg[1]; }
        __syncthreads();
    }
    bf16_t* orow = c.AB() + (size_t)(b * S + tq) * D + ocol;
    if (TYPE != 1) {
        const float lt = lrun[0] + __shfl_xor(lrun[0], 32), inv = 1.0f / lt;
#pragma unroll
        for (int db = 0; db < 2; ++db)
#pragma unroll
            for (int g = 0; g < 4; ++g) { u32x2 w; w.x = pk2(o[0][db][4 * g] * inv, o[0][db][4 * g + 1] * inv); w.y = pk2(o[0][db][4 * g + 2] * inv, o[0][db][4 * g + 3] * inv);
                *(u32x2*)(orow + 32 * db + 8 * g + 4 * hi) = w; }
    } else {
        float s1 = 0.f, s2 = 0.f;
        for (int i = 0; i < 32; ++i) { s1 += c.in(8)[l * 32 + i] * c.in(9)[l * 32 + i]; s2 += c.in(10)[l * 32 + i] * c.in(11)[l * 32 + i]; }
        const float lam_init = 0.8f - 0.6f * expf(-0.3f * (float)l);
        const float lam = expf(s1) - expf(s2) + lam_init;
        const float inv0 = 1.0f / (lrun[0] + __shfl_xor(lrun[0], 32)), inv1 = lam / (lrun[NMAP - 1] + __shfl_xor(lrun[NMAP - 1], 32));
        float ss = 0.f;
#pragma unroll
        for (int db = 0; db < 2; ++db)
#pragma unroll
            for (int r = 0; r < 16; ++r) { const float v = o[0][db][r] * inv0 - o[NMAP - 1][db][r] * inv1; o[0][db][r] = v; ss += v * v; }
        ss += __shfl_xor(ss, 32);
        const float rn = (1.0f - lam_init) / sqrtf(ss * (1.f / 64.f) + EPS);
        const float* gs = c.in(12) + l * 64;
#pragma unroll
        for (int db = 0; db < 2; ++db)
#pragma unroll
            for (int g = 0; g < 4; ++g) { const f32x4 gv = *(const f32x4*)(gs + 32 * db + 8 * g + 4 * hi);
                u32x2 w; w.x = pk2(o[0][db][4 * g] * rn * gv[0], o[0][db][4 * g + 1] * rn * gv[1]); w.y = pk2(o[0][db][4 * g + 2] * rn * gv[2], o[0][db][4 * g + 3] * rn * gv[3]);
                *(u32x2*)(orow + 32 * db + 8 * g + 4 * hi) = w; }
    }
}

constexpr int A6_KB0 = 0, A6_KB1 = 9216, A6_VB0 = 18432, A6_VB1 = 27648, A6_CUM = 36864, A6_SCR = 45056;
template <int TYPE>
__device__ __forceinline__ void attn_unit64(const Ctx& c, int l, int b, int h, int qb, LAS unsigned char* L) {
    constexpr int NMAP = TYPE == 1 ? 2 : 1, KS = 4 / NMAP;
    const int tid = otid(c.wv), lane = tid & 63, wave = __builtin_amdgcn_readfirstlane(tid >> 6), r32 = lane & 31, hi = lane >> 5;
    const bf16_t *Qp, *Kp, *Vp; int ocol;
    if (TYPE == 0) { Qp = c.FQ() + (size_t)(b * 6 + h) * S * 64; Kp = c.FK() + (size_t)(b * 6 + h) * S * 64; Vp = c.VT() + (size_t)(b * 11 + h) * 64 * S; ocol = 64 * h; }
    else if (TYPE == 1) { Qp = c.DQ() + (size_t)(b * 4 + h) * S * 64; Kp = c.DK() + (size_t)(b * 4 + h) * S * 64; Vp = c.VT() + (size_t)(b * 11 + 6 + h) * 64 * S; ocol = 384 + 64 * h; }
    else { Qp = c.SQ() + (size_t)(b * 6 + h) * S * 64; Kp = c.SK() + (size_t)b * S * 64; Vp = c.VT() + (size_t)(b * 11 + 10) * 64 * S; ocol = 640 + 64 * h; }
    const int q0 = 256 * qb, tq = q0 + 32 * wave + r32, nt = 4 * (qb + 1);
    const int srow = tid >> 3, sch = tid & 7;
    const bf16_t* kg = Kp + (size_t)srow * 64 + sch * 8;
    const bf16_t* vg = Vp + (size_t)srow * S + sch * 8;
    const unsigned soff = srow * 144 + sch * 16;
    u32x4 kreg[2], vreg[2];
    kreg[0] = *(const u32x4*)kg; vreg[0] = *(const u32x4*)vg; kreg[1] = *(const u32x4*)(kg + 4096); vreg[1] = *(const u32x4*)(vg + 64);
    bf16x8 qr[4];
#pragma unroll
    for (int d0 = 0; d0 < 4; ++d0) qr[d0] = *(const bf16x8*)(Qp + (size_t)tq * 64 + d0 * 16 + hi * 8);
    u32x4 mk0[4], mk1[4];
#pragma unroll
    for (int g = 0; g < 4; ++g) { mk0[g] = (u32x4){0u, 0u, 0u, 0u}; mk1[g] = (u32x4){0u, 0u, 0u, 0u}; }
    if (TYPE == 2) { const unsigned* mrow = c.MASK() + (size_t)(b * S + tq) * 64 + 4 * hi;
#pragma unroll
        for (int g = 0; g < 4; ++g) { mk0[g] = *(const u32x4*)(mrow + 8 * g); mk1[g] = *(const u32x4*)(mrow + 32 + 8 * g); } }
    LAS float* CUM = (LAS float*)(L + A6_CUM);
    if (TYPE == 0) {
        LAS float* SCR = (LAS float*)(L + A6_SCR);
        const f32x4 lf = *(const f32x4*)(c.LOGF() + (size_t)(b * 6 + h) * S + 4 * tid);
        const float a0 = lf[0], a1 = a0 + lf[1], a2 = a1 + lf[2], a3 = a2 + lf[3];
        float incl = a3;
#pragma unroll 1
        for (int off = 1; off < 64; off <<= 1) { const float n = __shfl_up(incl, off); if (lane >= off) incl += n; }
        if (lane == 63) SCR[wave] = incl;
        __syncthreads();
        float base = 0.f;
#pragma unroll
        for (int w = 0; w < NWAVES; ++w) if (w < wave) base += SCR[w];
        const float ex = incl - a3 + base;
        f32x4 cv; cv[0] = (ex + a0) * LOG2E; cv[1] = (ex + a1) * LOG2E; cv[2] = (ex + a2) * LOG2E; cv[3] = (ex + a3) * LOG2E;
        *(LAS f32x4*)(CUM + 4 * tid) = cv;
    }
    *(LAS u32x4*)(L + A6_KB0 + soff) = kreg[0]; *(LAS u32x4*)(L + A6_VB0 + soff) = vreg[0];
    __syncthreads();
    float cq = 0.f; if (TYPE == 0) cq = CUM[tq];
    float lrun[NMAP]; f32x16 o[NMAP][2];
#pragma unroll
    for (int mp = 0; mp < NMAP; ++mp) { lrun[mp] = 0.f;
#pragma unroll
        for (int r = 0; r < 16; ++r) { o[mp][0][r] = 0.f; o[mp][1][r] = 0.f; } }
#pragma unroll 1
    for (int j2 = 0; j2 < nt; j2 += 2) {
#pragma unroll
      for (int jp = 0; jp < 2; ++jp) {
        const int j = j2 + jp, cur = jp;
        if (j + 2 < nt) { kreg[jp] = *(const u32x4*)(kg + (size_t)(j + 2) * 4096); vreg[jp] = *(const u32x4*)(vg + (size_t)(j + 2) * 64); }
        const int jb = j - 4 * qb;
        const bool skip = (jb >= 0) && (64 * jb > 32 * wave + 31);
        if (!skip) {
            const LAS unsigned char* Kb = L + (cur ? A6_KB1 : A6_KB0);
            const LAS unsigned char* Vb = L + (cur ? A6_VB1 : A6_VB0);
#pragma unroll
            for (int mp = 0; mp < NMAP; ++mp) {
                f32x16 p0, p1;
                if (TYPE == 0) {
#pragma unroll
                    for (int g = 0; g < 4; ++g) { const f32x4 c0 = *(const LAS f32x4*)(CUM + 64 * j + 8 * g + 4 * hi), c1 = *(const LAS f32x4*)(CUM + 64 * j + 32 + 8 * g + 4 * hi);
#pragma unroll
                        for (int i = 0; i < 4; ++i) { p0[4 * g + i] = cq - c0[i]; p1[4 * g + i] = cq - c1[i]; } }
                } else {
#pragma unroll
                    for (int r = 0; r < 16; ++r) { p0[r] = 0.f; p1[r] = 0.f; }
                }
#pragma unroll
                for (int ks = 0; ks < KS; ++ks) { const int d0 = mp * KS + ks;
                    const bf16x8 a0 = *(const LAS bf16x8*)(Kb + r32 * 144 + d0 * 32 + hi * 16);
                    const bf16x8 a1 = *(const LAS bf16x8*)(Kb + (32 + r32) * 144 + d0 * 32 + hi * 16);
                    p0 = __builtin_amdgcn_mfma_f32_32x32x16_bf16(a0, qr[d0], p0, 0, 0, 0);
                    p1 = __builtin_amdgcn_mfma_f32_32x32x16_bf16(a1, qr[d0], p1, 0, 0, 0); }
                if (TYPE != 2) {
                    if (jb >= 0) { const int base = tq - 64 * j - 4 * hi;
#pragma unroll
                        for (int r = 0; r < 16; ++r) { const int kk = (r & 3) + 8 * (r >> 2); if (kk > base) p0[r] = NEGBIG; if (kk + 32 > base) p1[r] = NEGBIG; } }
                }
                float ls = 0.f;
                if (TYPE == 2) {
#pragma unroll
                    for (int r = 0; r < 16; ++r) {
                        const int m0 = __builtin_amdgcn_sbfe((int)mk0[r >> 2][r & 3], (unsigned)j, 1u), m1 = __builtin_amdgcn_sbfe((int)mk1[r >> 2][r & 3], (unsigned)j, 1u);
                        p0[r] = __builtin_bit_cast(float, __builtin_bit_cast(int, __builtin_amdgcn_exp2f(p0[r])) & m0);
                        p1[r] = __builtin_bit_cast(float, __builtin_bit_cast(int, __builtin_amdgcn_exp2f(p1[r])) & m1); ls += p0[r] + p1[r]; }
                } else {
#pragma unroll
                for (int r = 0; r < 16; ++r) { p0[r] = __builtin_amdgcn_exp2f(p0[r]); p1[r] = __builtin_amdgcn_exp2f(p1[r]); ls += p0[r] + p1[r]; }
                }
                lrun[mp] += ls;
                u32x4 pw[2][2];
#pragma unroll
                for (int cc = 0; cc < 2; ++cc) {
                    pw[0][cc].x = pk2(p0[8 * cc + 0], p0[8 * cc + 1]); pw[0][cc].y = pk2(p0[8 * cc + 2], p0[8 * cc + 3]); pw[0][cc].z = pk2(p0[8 * cc + 4], p0[8 * cc + 5]); pw[0][cc].w = pk2(p0[8 * cc + 6], p0[8 * cc + 7]);
                    pw[1][cc].x = pk2(p1[8 * cc + 0], p1[8 * cc + 1]); pw[1][cc].y = pk2(p1[8 * cc + 2], p1[8 * cc + 3]); pw[1][cc].z = pk2(p1[8 * cc + 4], p1[8 * cc + 5]); pw[1][cc].w = pk2(p1[8 * cc + 6], p1[8 * cc + 7]); }
#pragma unroll
                for (int pp = 0; pp < 2; ++pp)
#pragma unroll
                    for (int cc = 0; cc < 2; ++cc)
#pragma unroll
                        for (int db = 0; db < 2; ++db) {
                            const bf16x8 av = *(const LAS bf16x8*)(Vb + (32 * db + r32) * 144 + pp * 64 + hi * 32 + cc * 16);
                            o[mp][db] = __builtin_amdgcn_mfma_f32_32x32x16_bf16(av, __builtin_bit_cast(bf16x8, pw[pp][cc]), o[mp][db], 0, 0, 0); }
            }
        }
        if (j + 1 < nt) { *(LAS u32x4*)(L + (cur ? A6_KB0 : A6_KB1) + soff) = kreg[jp ^ 1]; *(LAS u32x4*)(L + (cur ? A6_VB0 : A6_VB1) + soff) = vreg[jp ^ 1]; }
        __syncthreads();
      }
    }
    bf16_t* orow = c.AB() + (size_t)(b * S + tq) * D + ocol;
    if (TYPE != 1) {
        const float lt = lrun[0] + __shfl_xor(lrun[0], 32), inv = 1.0f / lt;
#pragma unroll
        for (int db = 0; db < 2; ++db)
#pragma unroll
            for (int g = 0; g < 4; ++g) { u32x2 w; w.x = pk2(o[0][db][4 * g] * inv, o[0][db][4 * g + 1] * inv); w.y = pk2(o[0][db][4 * g + 2] * inv, o[0][db][4 * g + 3] * inv);
                *(u32x2*)(orow + 32 * db + 8 * g + 4 * hi) = w; }
    } else {
        float s1 = 0.f, s2 = 0.f;
        for (int i = 0; i < 32; ++i) { s1 += c.in(8)[l * 32 + i] * c.in(9)[l * 32 + i]; s2 += c.in(10)[l * 32 + i] * c.in(11)[l * 32 + i]; }
        const float lam_init = 0.8f - 0.6f * expf(-0.3f * (float)l);
        const float lam = expf(s1) - expf(s2) + lam_init;
        const float inv0 = 1.0f / (lrun[0] + __shfl_xor(lrun[0], 32)), inv1 = lam / (lrun[NMAP - 1] + __shfl_xor(lrun[NMAP - 1], 32));
        float ss = 0.f;
#pragma unroll
        for (int db = 0; db < 2; ++db)
#pragma unroll
            for (int r = 0; r < 16; ++r) { const float v = o[0][db][r] * inv0 - o[NMAP - 1][db][r] * inv1; o[0][db][r] = v; ss += v * v; }
        ss += __shfl_xor(ss, 32);
        const float rn = (1.0f - lam_init) / sqrtf(ss * (1.f / 64.f) + EPS);
        const float* gs = c.in(12) + l * 64;
#pragma unroll
        for (int db = 0; db < 2; ++db)
#pragma unroll
            for (int g = 0; g < 4; ++g) { const f32x4 gv = *(const f32x4*)(gs + 32 * db + 8 * g + 4 * hi);
                u32x2 w; w.x = pk2(o[0][db][4 * g] * rn * gv[0], o[0][db][4 * g + 1] * rn * gv[1]); w.y = pk2(o[0][db][4 * g + 2] * rn * gv[2], o[0][db][4 * g + 3] * rn * gv[3]);
                *(u32x2*)(orow + 32 * db + 8 * g + 4 * hi) = w; }
    }
}

#define XB_TMO      128
#define XB_XCNT(j)  (256  + 64 * (j))
#define XB_XSUB(j)  (1280 + 64 * (j))
#define XB_XGEN(j)  (2304 + 64 * (j))
#define XB_TOP      3328
#define XB_TOPGEN   3392
#define XCD_BAR_WORDS 3456
#define XB_SPIN_CAP (1u << 18)

__device__ __forceinline__ unsigned xb_ld(unsigned* p)              { return __hip_atomic_load(p, __ATOMIC_RELAXED, __HIP_MEMORY_SCOPE_AGENT); }
__device__ __forceinline__ unsigned xb_add(unsigned* p, unsigned v) { return __hip_atomic_fetch_add(p, v, __ATOMIC_RELAXED, __HIP_MEMORY_SCOPE_AGENT); }
__device__ __forceinline__ unsigned xb_xcc_id() { return (unsigned)__builtin_amdgcn_s_getreg((3 << 11) | 20) & 0xFu; }
#define XB_SPIN(cond, bar) do { unsigned _sp = 0; while (cond) {   \
    if ((++_sp & 255u) == 0u) { if (xb_ld(&(bar)[XB_TMO])) break; if (_sp > XB_SPIN_CAP) { atomicAdd(&(bar)[XB_TMO], 1u); break; } } } } while (0)

struct XcdBarrier {
    unsigned* bar; unsigned x; int wv;
    volatile LAS unsigned* st;
};

__device__ __forceinline__ XcdBarrier xcd_barrier_post(unsigned* bar, volatile LAS unsigned* st, int wv) {
    XcdBarrier b; b.bar = bar; b.x = xb_xcc_id(); b.st = st; b.wv = wv;
    if (wv == 0 && lane_id() == 0) (void)xb_add(&bar[XB_XCNT(b.x)], 1u);
    return b;
}
__device__ __forceinline__ void xcd_barrier_complete(unsigned* bar, unsigned x, unsigned& nloc, unsigned& nx) {
    const unsigned G = gridDim.x * gridDim.y * gridDim.z;
    unsigned sum, cnt, mine, sp = 0u;
    for (;;) {
        sum = 0u; cnt = 0u; mine = 0u;
#pragma unroll
        for (unsigned j = 0; j < 16; ++j) { const unsigned c = xb_ld(&bar[XB_XCNT(j)]); sum += c; cnt += (c > 0u) ? 1u : 0u; mine = (j == x) ? c : mine; }
        if (sum == G) break;
        __builtin_amdgcn_s_sleep(1);
        if ((++sp & 255u) == 0u) { if (xb_ld(&bar[XB_TMO])) break; if (sp > XB_SPIN_CAP) { atomicAdd(&bar[XB_TMO], 1u); break; } }
    }
    nloc = mine > 0u ? mine : 1u; nx = cnt > 0u ? cnt : 1u;
}

__device__ __forceinline__ void xcd_barrier(const XcdBarrier& b) {
    asm volatile("s_waitcnt vmcnt(0)" ::: "memory");
    __syncthreads();
    if (b.wv == 0 && lane_id() == 0) {
        unsigned* bar = b.bar;
        __builtin_amdgcn_s_waitcnt(0);
        unsigned nloc = b.st[0], nx = b.st[1];
        if (nloc == 0u) { xcd_barrier_complete(bar, b.x, nloc, nx); b.st[0] = nloc; b.st[1] = nx; }
        const unsigned old = xb_add(&bar[XB_XSUB(b.x)], 1u);
        const unsigned gen = old / nloc;
        if (old + 1u == (gen + 1u) * nloc) {
            __builtin_amdgcn_fence(__ATOMIC_RELEASE, "agent");
            asm volatile("s_waitcnt vmcnt(0)" ::: "memory");
            const unsigned og = xb_add(&bar[XB_TOP], 1u);
            const unsigned tg = og / nx;
            asm volatile("buffer_inv sc1" ::: "memory");
            if (og + 1u == (tg + 1u) * nx) xb_add(&bar[XB_TOPGEN], 1u);
            else XB_SPIN(xb_ld(&bar[XB_TOPGEN]) == tg, bar);
            asm volatile("" ::: "memory");
            xb_add(&bar[XB_XGEN(b.x)], 1u);
            asm volatile("s_waitcnt vmcnt(0)" ::: "memory");
        } else {
            asm volatile("buffer_inv sc1" ::: "memory");
            XB_SPIN(xb_ld(&bar[XB_XGEN(b.x)]) == gen, bar);
            asm volatile("" ::: "memory");
            asm volatile("s_waitcnt vmcnt(0)" ::: "memory");
        }
    }
    __syncthreads();
}

__global__ void __launch_bounds__(NTHR, 2) trunk_fwd(Args a) {
    extern __shared__ __attribute__((aligned(16))) unsigned char lds[];
    cg::grid_group grid = cg::this_grid();
    LAS unsigned char* L = (LAS unsigned char*)lds;
    const int wv = __builtin_amdgcn_readfirstlane((int)threadIdx.x >> 6);
    const Ctx c{a, wv};
    volatile LAS unsigned* xst = (volatile LAS unsigned*)(L + 147200);
    if (wv == 0 && lane_id() == 0) { xst[0] = 0u; xst[1] = 0u; }
    __syncthreads();
    unsigned* barw = (unsigned*)(a.ws + WS_BAR);
    XcdBarrier xbar; xbar.bar = barw; xbar.x = 0; xbar.st = xst; xbar.wv = wv;
    const int lo = a.ph_lo, hi = a.ph_hi, G = gridDim.x, cid = blockIdx.x;
#ifndef PHMASK
#define PHMASK 0xFF
#endif
#define PK_(k) (((PHMASK) >> (k)) & 1)
#ifndef DUPMASK
#define DUPMASK 0
#endif
#define REP_(k) for (int rep_ = 0; rep_ < 1 + (((DUPMASK) >> (k)) & 1); ++rep_)
#define RUN(p) ((p) >= lo && (p) < hi)
#define SEAM(p) do { if (RUN(p) && RUN((p) + 1)) { REP_(8) xcd_barrier(xbar); } } while (0)
    xbar = xcd_barrier_post(barw, xst, wv);
    if (lo < 0) grid.sync();
    if (PK_(0) && RUN(0)) REP_(0) phase0(c, a, L);
    xcd_barrier(xbar);
#pragma unroll 1
    for (int l = 0; l < DEPTH; ++l) {
        const int pb = 1 + 7 * l;
        const float* xin = l == 0 ? c.in(0) : c.out();
        if (PK_(2) && RUN(pb + 0)) REP_(2) { pg8::Gemm g{c.XB(), c.Win() + (size_t)l * INP * D, M, INP, D}; pg8::StaticOrder So; So.init(M, INP, G, cid);
            EpiProj E{c.PROJ(), c.SIDE(), c.SSQ()}; pg8::gemm_phase<EpiProj, pg8::StaticOrder, true, true>(L, g, So, E, wv); }
        SEAM(pb + 0);
        if (PK_(3) && RUN(pb + 1)) REP_(3) prep_phase(c, l, L);
        SEAM(pb + 1);
        if (PK_(4) && RUN(pb + 2)) REP_(4) {
            const int rounds = (NB * 128 + G - 1) / G;
            for (int i = 0; i < rounds; ++i) { const int Lx = i * G + ((i & 1) ? G - 1 - cid : cid); if (Lx < NB * 128) idx_unit(c, Lx % NB, 127 - Lx / NB, L); }
        }
        SEAM(pb + 2);
        if (PK_(5) && RUN(pb + 3)) REP_(5) {
            if (G == 256) {
                const int qd = cid >> 5, i32 = cid & 31;
                const unsigned tab = qd == 7 ? (0u | 4u << 5 | 20u << 10) : qd == 6 ? (1u | 8u << 5 | 21u << 10) : qd == 5 ? (2u | 12u << 5 | 24u << 10) : qd == 4 ? (5u | 9u << 5 | 28u << 10)
                                   : qd == 3 ? (6u | 13u << 5 | 29u << 10) : qd == 2 ? (10u | 16u << 5 | 25u << 10) : qd == 1 ? (14u | 17u << 5 | 30u << 10) : (18u | 22u << 5 | 26u << 10);
#ifndef ATT_ONLY
#define ATT_ONLY 7
#endif
                if (ATT_ONLY & 2) attn_unit64<1>(c, l, i32 / 4, i32 % 4, qd, L);
#pragma unroll 1
                for (int k = 2; k >= 0; --k) { const unsigned e = (tab >> (5 * k)) & 31u; const int qb = (int)(e >> 2), u = 32 * (int)(e & 3u) + i32;
                    if (u < 48) { if (ATT_ONLY & 1) attn_unit<0>(c, l, u / 6, u % 6, qb, L); } else { if (ATT_ONLY & 4) attn_unit64<2>(c, l, (u - 48) / 6, (u - 48) % 6, qb, L); } }
            } else {
                const int rounds = (1024 + G - 1) / G;
                for (int i = 0; i < rounds; ++i) { const int Lx = i * G + ((i & 1) ? G - 1 - cid : cid);
                    if (Lx < 1024) { const int qb = 7 - Lx / 128, w = Lx % 128;
                        if (w < 32) { if (ATT_ONLY & 2) attn_unit64<1>(c, l, w / 4, w % 4, qb, L); }
                        else if (w < 80) { if (ATT_ONLY & 1) attn_unit<0>(c, l, (w - 32) / 6, (w - 32) % 6, qb, L); }
                        else { if (ATT_ONLY & 4) attn_unit64<2>(c, l, (w - 80) / 6, (w - 80) % 6, qb, L); } } }
            }
        }
        SEAM(pb + 3);
        if (PK_(6) && RUN(pb + 4)) { pg8::Gemm g{c.AB(), c.Wout() + (size_t)l * D * D, M, D, D}; pg8::StaticOrder So; So.init(M, D, G, cid);
            EpiResid E{xin, c.out(), c.XB(), c.SSQ() + (size_t)16 * M}; pg8::gemm_phase<EpiResid, pg8::StaticOrder, true, true>(L, g, So, E, wv); }
        SEAM(pb + 4);
        if (PK_(7) && RUN(pb + 5)) REP_(7) { pg8::Gemm g{c.XB(), c.Wgu() + (size_t)l * GU * D, M, GU, D}; pg8::StaticOrder So; So.init(M, GU, G, cid);
            EpiSwiglu E{c.PROJ(), c.SSQ() + (size_t)16 * M}; pg8::gemm_phase<EpiSwiglu, pg8::StaticOrder, true, true>(L, g, So, E, wv);
            if (l + 1 < DEPTH && G == 256 && cid >= 128) { const int tid2 = otid(wv); convert_layer(c, l + 1, (cid - 128) * NWAVES + (tid2 >> 6), 128 * NWAVES, (LAS float*)(L + (tid2 >> 6) * 16640), tid2 & 63); } }
        SEAM(pb + 5);
        if (PK_(6) && RUN(pb + 6)) { pg8::Gemm g{c.PROJ(), c.Wdn() + (size_t)l * D * FF, M, D, FF}; pg8::StaticOrder So; So.init(M, D, G, cid);
            EpiResid E{c.out(), c.out(), l + 1 < DEPTH ? c.XB() : nullptr, c.SSQ()}; pg8::gemm_phase<EpiResid, pg8::StaticOrder, true, true>(L, g, So, E, wv); }
        SEAM(pb + 6);
    }
#undef RUN
#undef SEAM
}

extern "C" void kernel_launch(void* const* d_in, const int* in_sizes, int n_in, void* d_out, int out_size, void* d_ws, size_t ws_size, hipStream_t stream) {
    static int grid = 0;
    if (grid == 0) {
        if (n_in != 19 || in_sizes[0] != M * D || out_size != M * D || ws_size < WS_END) { fprintf(stderr, "kernel_launch: shape/workspace mismatch (n_in %d, in0 %d, out %d, ws %zu < %zu)\n", n_in, n_in > 0 ? in_sizes[0] : -1, out_size, ws_size, (size_t)WS_END); grid = -1; return; }
        int dev = 0, cus = 0, per_cu = 0;
        (void)hipGetDevice(&dev); (void)hipDeviceGetAttribute(&cus, hipDeviceAttributeMultiprocessorCount, dev);
        if (hipFuncSetAttribute((const void*)trunk_fwd, hipFuncAttributeMaxDynamicSharedMemorySize, LDS_BYTES) != hipSuccess) { fprintf(stderr, "kernel_launch: hipFuncSetAttribute failed\n"); grid = -1; return; }
        if (hipOccupancyMaxActiveBlocksPerMultiprocessor(&per_cu, (const void*)trunk_fwd, NTHR, LDS_BYTES) != hipSuccess || per_cu < 1) { fprintf(stderr, "kernel_launch: occupancy query says %d\n", per_cu); per_cu = 1; }
        (void)hipGetLastError();
        grid = cus * 1;
        (void)per_cu;
    }
    if (grid < 0) return;
    if (hipMemsetAsync((char*)d_ws + WS_BAR, 0, XCD_BAR_WORDS * 4, stream) != hipSuccess) { fprintf(stderr, "kernel_launch: hipMemsetAsync of the barrier words failed\n"); return; }
    Args a{};
    for (int i = 0; i < 19; ++i) a.in[i] = (const float*)d_in[i];
    a.out = (float*)d_out; a.ws = (unsigned char*)d_ws;
    for (int i = 0; i < 8; ++i) a.invf[i] = 1.0f / (float)pow(500000.0, (double)i / 8.0);
    for (int i = 0; i < 4; ++i) a.invf[8 + i] = 1.0f / (float)pow(500000.0, (double)i / 4.0);
    a.ph_lo = 0; a.ph_hi = NPH;
    void* args[] = {&a};
    hipError_t e = hipLaunchCooperativeKernel((const void*)trunk_fwd, dim3(grid), dim3(NTHR), args, LDS_BYTES, stream);
    if (e != hipSuccess) fprintf(stderr, "cooperative launch failed: %s (grid %d)\n", hipGetErrorString(e), grid);
}
```
